# Optimizing an MI355X kernel written in HIP

```python
import jax
import jax.numpy as jnp
from jax import lax
import numpy as np

D_MODEL = 1024
BATCH = 2
SEQ = 8192
DEPTH = 4

GRID_W = 64
CTX_LEN = 256
N_MIXERS = 4
N_MLA_LAYERS = (DEPTH + 3) // 4
N_GQA_LAYERS = (DEPTH + 2) // 4
N_NA_LAYERS = (DEPTH + 1) // 4
N_RET_LAYERS = DEPTH // 4
Q_BLOCK = 128
ROPE_THETA = 10000.0
EPS = 1e-6
MLA_HEADS = 8
MLA_Q_RANK = 384
MLA_KV_RANK = 256
MLA_NOPE = 128
MLA_ROPE = 64
MLA_QK = MLA_NOPE + MLA_ROPE
MLA_V = 128
GQA_HEADS = 8
GQA_KV_HEADS = 2
GQA_HEAD_DIM = 128
NA_HEADS = 16
NA_HEAD_DIM = 64
NA_WIN_ROWS = 8
NA_WIN_COLS = 16
RET_HEADS = 4
RET_QK_DIM = 256
RET_V_DIM = 512
RET_CHUNK = 128
FFN_HIDDEN = ((8 * D_MODEL + 3 * 256 - 1) // (3 * 256)) * 256
F32 = jnp.float32

kernel_name = 'hybrid_diffusion_interleaved_mixers'


def rms_norm(x, gain):
    xf = x.astype(F32)
    y = xf * lax.rsqrt(jnp.mean(xf * xf, axis=-1, keepdims=True) + EPS)
    return (y * gain.astype(F32)).astype(x.dtype)


def rope_tables(length, dim):
    t = jnp.arange(length)
    row = (t // GRID_W).astype(F32)
    col = (t % GRID_W).astype(F32)
    quarter = dim // 4
    inv_freq = ROPE_THETA ** (-jnp.arange(quarter, dtype=F32) / quarter)
    ang = jnp.concatenate([row[:, None] * inv_freq, col[:, None] * inv_freq], axis=-1)
    return jnp.cos(ang), jnp.sin(ang)


def apply_rope(x, cos, sin):
    half = x.shape[-1] // 2
    xf = x.astype(F32)
    x1, x2 = xf[..., :half], xf[..., half:]
    c, s = cos[None, :, None, :], sin[None, :, None, :]
    return jnp.concatenate([x1 * c - x2 * s, x1 * s + x2 * c], axis=-1).astype(x.dtype)


def dense_attention(q, k, v, scale):
    b, s, h, dq = q.shape
    kvh, dv = k.shape[2], v.shape[-1]
    g = h // kvh
    qb = q.reshape(b, s // Q_BLOCK, Q_BLOCK, kvh, g, dq).transpose(1, 0, 2, 3, 4, 5)

    def block(q_blk):
        sc = jnp.einsum('bqkgd,btkd->bkgqt', q_blk, k).astype(F32) * scale
        p = jax.nn.softmax(sc, axis=-1).astype(v.dtype)
        return jnp.einsum('bkgqt,btkd->bqkgd', p, v)

    o = lax.map(block, qb)
    return o.transpose(1, 0, 2, 3, 4, 5).reshape(b, s, h, dv)


def joint_attention(ql, kl, vl, qc, kc, vc, scale):
    ol = dense_attention(ql, jnp.concatenate([kc, kl], axis=1), jnp.concatenate([vc, vl], axis=1), scale)
    oc = dense_attention(qc, kc, vc, scale) if qc is not None else None
    return ol, oc


def merge_heads(o, w_o):
    return o.reshape(o.shape[0], o.shape[1], -1) @ w_o


def mla_mixer(xl, xc, w_down, q_lora_norm, kv_lora_norm, w_uq, w_ukv, q_norm, k_norm, w_o, need_ctx):
    b, s, _ = xl.shape
    cos, sin = rope_tables(s, MLA_ROPE)

    def queries(c_q):
        q = (rms_norm(c_q, q_lora_norm) @ w_uq).reshape(b, c_q.shape[1], MLA_HEADS, MLA_QK)
        return rms_norm(q, q_norm)

    def keys_values(c_kv, k_rope):
        l = c_kv.shape[1]
        kv = (rms_norm(c_kv, kv_lora_norm) @ w_ukv).reshape(b, l, MLA_HEADS, MLA_NOPE + MLA_V)
        k = jnp.concatenate([kv[..., :MLA_NOPE],
                             jnp.broadcast_to(k_rope[:, :, None, :], (b, l, MLA_HEADS, MLA_ROPE))], axis=-1)
        return rms_norm(k, k_norm), kv[..., MLA_NOPE:]

    def rotate(t):
        return jnp.concatenate([t[..., :MLA_NOPE], apply_rope(t[..., MLA_NOPE:], cos, sin)], axis=-1)

    dl = xl @ w_down
    ql = rotate(queries(dl[..., :MLA_Q_RANK]))
    kl, vl = keys_values(dl[..., MLA_Q_RANK:MLA_Q_RANK + MLA_KV_RANK], dl[..., MLA_Q_RANK + MLA_KV_RANK:])
    kl = rotate(kl)
    if need_ctx:
        dc = xc @ w_down
        qc = queries(dc[..., :MLA_Q_RANK])
        dkv = dc[..., MLA_Q_RANK:]
    else:
        qc = None
        dkv = xc @ w_down[:, MLA_Q_RANK:]
    kc, vc = keys_values(dkv[..., :MLA_KV_RANK], dkv[..., MLA_KV_RANK:])
    ol, oc = joint_attention(ql, kl, vl, qc, kc, vc, MLA_QK ** -0.5)
    return merge_heads(ol, w_o), (merge_heads(oc, w_o) if need_ctx else None)


def gqa_project(x, w_qkv, q_norm, k_norm, with_q):
    b, l, _ = x.shape
    nq = GQA_HEADS * GQA_HEAD_DIM
    if with_q:
        p = x @ w_qkv
        q = rms_norm(p[..., :nq].reshape(b, l, GQA_HEADS, GQA_HEAD_DIM), q_norm)
        p = p[..., nq:]
    else:
        q = None
        p = x @ w_qkv[:, nq:]
    kv = p.reshape(b, l, 2, GQA_KV_HEADS, GQA_HEAD_DIM)
    return q, rms_norm(kv[:, :, 0], k_norm), kv[:, :, 1]


def gqa_mixer(xl, xc, w_qkv, q_norm, k_norm, w_o, need_ctx):
    cos, sin = rope_tables(xl.shape[1], GQA_HEAD_DIM)
    ql, kl, vl = gqa_project(xl, w_qkv, q_norm, k_norm, True)
    ql, kl = apply_rope(ql, cos, sin), apply_rope(kl, cos, sin)
    qc, kc, vc = gqa_project(xc, w_qkv, q_norm, k_norm, need_ctx)
    ol, oc = joint_attention(ql, kl, vl, qc, kc, vc, GQA_HEAD_DIM ** -0.5)
    return merge_heads(ol, w_o), (merge_heads(oc, w_o) if need_ctx else None)


def na_project(x, w_qkv, q_norm, k_norm, with_q):
    b, l, _ = x.shape
    nq = NA_HEADS * NA_HEAD_DIM
    if with_q:
        p = x @ w_qkv
        q = rms_norm(p[..., :nq].reshape(b, l, NA_HEADS, NA_HEAD_DIM), q_norm)
        p = p[..., nq:]
    else:
        q = None
        p = x @ w_qkv[:, nq:]
    kv = p.reshape(b, l, 2, NA_HEADS, NA_HEAD_DIM)
    return q, rms_norm(kv[:, :, 0], k_norm), kv[:, :, 1]


def na_mixer(xl, xc, w_qkv, q_norm, k_norm, rpb, w_o, need_ctx):
    b, s, _ = xl.shape
    rows = s // GRID_W
    wr = min(NA_WIN_ROWS, rows)
    wc = NA_WIN_COLS
    scale = NA_HEAD_DIM ** -0.5
    ql, kl, vl = na_project(xl, w_qkv, q_norm, k_norm, True)
    qc, kc, vc = na_project(xc, w_qkv, q_norm, k_norm, need_ctx)
    qg = ql.reshape(b, rows, GRID_W, NA_HEADS, NA_HEAD_DIM).transpose(1, 0, 2, 3, 4)
    kg = kl.reshape(b, rows, GRID_W, NA_HEADS, NA_HEAD_DIM)
    vg = vl.reshape(b, rows, GRID_W, NA_HEADS, NA_HEAD_DIM)
    col = jnp.arange(GRID_W)
    col_start = jnp.clip(col - wc // 2, 0, GRID_W - wc)
    col_idx = col_start[:, None] + jnp.arange(wc)[None, :]
    col_rel = col_idx - col[:, None] + (NA_WIN_COLS - 1)

    def one_row(args):
        r, q_r = args
        r0 = jnp.clip(r - wr // 2, 0, rows - wr)
        k_win = lax.dynamic_slice_in_dim(kg, r0, wr, axis=1)[:, :, col_idx]
        v_win = lax.dynamic_slice_in_dim(vg, r0, wr, axis=1)[:, :, col_idx]
        row_rel = r0 + jnp.arange(wr) - r + (NA_WIN_ROWS - 1)
        bias = rpb[:, row_rel[:, None, None], col_rel[None, :, :]]
        s_loc = jnp.einsum('bqhd,bwqjhd->bhqwj', q_r, k_win).astype(F32) * scale
        s_loc = s_loc + bias.transpose(0, 2, 1, 3)[None].astype(F32)
        s_ctx = jnp.einsum('bqhd,bthd->bhqt', q_r, kc).astype(F32) * scale
        sc = jnp.concatenate([s_loc.reshape(b, NA_HEADS, GRID_W, wr * wc), s_ctx], axis=-1)
        p = jax.nn.softmax(sc, axis=-1).astype(vl.dtype)
        p_loc = p[..., :wr * wc].reshape(b, NA_HEADS, GRID_W, wr, wc)
        p_ctx = p[..., wr * wc:]
        return (jnp.einsum('bhqwj,bwqjhd->bqhd', p_loc, v_win)
                + jnp.einsum('bhqt,bthd->bqhd', p_ctx, vc))

    o = lax.map(one_row, (jnp.arange(rows), qg))
    ol = o.transpose(1, 0, 2, 3, 4).reshape(b, s, NA_HEADS * NA_HEAD_DIM) @ w_o
    oc = merge_heads(dense_attention(qc, kc, vc, scale), w_o) if need_ctx else None
    return ol, oc


def ret_project(x, w_qkvg, with_qg):
    b, l, _ = x.shape
    nk, nv = RET_HEADS * RET_QK_DIM, RET_HEADS * RET_V_DIM
    if with_qg:
        p = x @ w_qkvg
        q = p[..., :nk].reshape(b, l, RET_HEADS, RET_QK_DIM)
        g = p[..., 2 * nk + nv:]
        p = p[..., nk:2 * nk + nv]
    else:
        q = g = None
        p = x @ w_qkvg[:, nk:2 * nk + nv]
    k = p[..., :nk].reshape(b, l, RET_HEADS, RET_QK_DIM) * (RET_QK_DIM ** -0.5)
    v = p[..., nk:].reshape(b, l, RET_HEADS, RET_V_DIM)
    return q, k, v, g


def ret_context_state(k, v, log_decay, reverse):
    lc = k.shape[1]
    pos = jnp.arange(lc, dtype=F32)
    age = pos if reverse else (lc - 1 - pos)
    w = jnp.exp(age[:, None] * log_decay.astype(F32)[None, :])
    return jnp.einsum('bthk,bthv->bhkv', k.astype(F32) * w[None, :, :, None], v.astype(F32))


def chunk_retention(q, k, v, log_decay, init_state):
    b, l, h, dk = q.shape
    dv = v.shape[-1]
    n = l // RET_CHUNK
    ld = log_decay.astype(F32)
    i = jnp.arange(RET_CHUNK, dtype=F32)
    dist = i[:, None] - i[None, :]
    intra = jnp.where(dist >= 0, jnp.exp(jnp.maximum(dist, 0.0)[None] * ld[:, None, None]), 0.0)
    q_decay = jnp.exp((i + 1.0)[:, None] * ld[None, :])
    k_decay = jnp.exp((RET_CHUNK - 1.0 - i)[:, None] * ld[None, :])
    chunk_decay = jnp.exp(RET_CHUNK * ld)

    def split_chunks(t):
        return t.reshape(b, n, RET_CHUNK, h, t.shape[-1]).transpose(1, 0, 2, 3, 4)

    def step(state, blk):
        qc, kc, vc = blk
        qf, kf, vf = qc.astype(F32), kc.astype(F32), vc.astype(F32)
        sc = jnp.einsum('bqhk,bthk->bhqt', qf, kf) * intra[None]
        inner = jnp.einsum('bhqt,bthv->bqhv', sc, vf)
        cross = jnp.einsum('bqhk,bhkv->bqhv', qf, state) * q_decay[None, :, :, None]
        new_state = (state * chunk_decay[None, :, None, None]
                     + jnp.einsum('bthk,bthv->bhkv', kf * k_decay[None, :, :, None], vf))
        return new_state, (inner + cross).astype(q.dtype)

    _, out = lax.scan(step, init_state, (split_chunks(q), split_chunks(k), split_chunks(v)))
    return out.transpose(1, 0, 2, 3, 4).reshape(b, l, h, dv)


def ret_output(y, g, out_norm, w_o, dtype):
    b, l, h, dv = y.shape
    mu = jnp.mean(y, axis=-1, keepdims=True)
    var = jnp.mean(jnp.square(y - mu), axis=-1, keepdims=True)
    yn = ((y - mu) * lax.rsqrt(var + EPS)).reshape(b, l, h * dv) * out_norm.astype(F32)
    return (yn * jax.nn.silu(g.astype(F32))).astype(dtype) @ w_o


def ret_mixer(xl, xc, w_qkvg, log_decay_fwd, log_decay_bwd, out_norm, w_o, need_ctx):
    cos, sin = rope_tables(xl.shape[1], RET_QK_DIM)
    ql, kl, vl, gl = ret_project(xl, w_qkvg, True)
    ql, kl = apply_rope(ql, cos, sin), apply_rope(kl, cos, sin)
    qc, kc, vc, gc = ret_project(xc, w_qkvg, need_ctx)
    state_f = ret_context_state(kc, vc, log_decay_fwd, False)
    state_b = ret_context_state(kc, vc, log_decay_bwd, True)
    yf = chunk_retention(ql, kl, vl, log_decay_fwd, state_f)
    yb = jnp.flip(chunk_retention(jnp.flip(ql, 1), jnp.flip(kl, 1), jnp.flip(vl, 1),
                                  log_decay_bwd, state_b), 1)
    ol = ret_output(yf.astype(F32) + yb.astype(F32), gl, out_norm, w_o, xl.dtype)
    oc = None
    if need_ctx:
        lc = xc.shape[1]
        pos = jnp.arange(lc, dtype=F32)
        dist = pos[:, None] - pos[None, :]
        lf = log_decay_fwd.astype(F32)[:, None, None]
        lb = log_decay_bwd.astype(F32)[:, None, None]
        dec = (jnp.where(dist >= 0, jnp.exp(jnp.maximum(dist, 0.0)[None] * lf), 0.0)
               + jnp.where(dist <= 0, jnp.exp(jnp.maximum(-dist, 0.0)[None] * lb), 0.0))
        sc = jnp.einsum('bqhk,bthk->bhqt', qc, kc).astype(F32) * dec[None]
        yc = jnp.einsum('bhqt,bthv->bqhv', sc, vc.astype(F32))
        oc = ret_output(yc, gc, out_norm, w_o, xc.dtype)
    return ol, oc


def swiglu(x, w13, w2):
    a = x @ w13
    return (jax.nn.silu(a[..., :FFN_HIDDEN]) * a[..., FFN_HIDDEN:]) @ w2


def setup_inputs(seed: int = 0) -> dict:
    key = jax.random.key(seed)
    keys = iter(jax.random.split(key, 40))
    D = D_MODEL

    def nrm(shape, scale):
        return scale * jax.random.normal(next(keys), shape, F32)

    def gain(shape):
        return 1.0 + nrm(shape, 0.02)

    base_decay = jnp.log(1.0 - 2.0 ** (-5.0 - jnp.arange(RET_HEADS, dtype=F32)))
    nk, nv = RET_HEADS * RET_QK_DIM, RET_HEADS * RET_V_DIM
    return {
        'x': nrm((BATCH, SEQ, D), 1.0),
        'c': nrm((BATCH, D), 1.0),
        'ctx': nrm((BATCH, CTX_LEN, D), 1.0),
        'c_ctx': nrm((D,), 1.0),
        'mod_w': nrm((DEPTH, D, 6 * D), 0.5 * D ** -0.5),
        'mod_b': nrm((DEPTH, 6 * D), 0.01),
        'norm1': gain((DEPTH, D)),
        'norm2': gain((DEPTH, D)),
        'ffn_w13': nrm((DEPTH, D, 2 * FFN_HIDDEN), D ** -0.5),
        'ffn_w2': nrm((DEPTH, FFN_HIDDEN, D), FFN_HIDDEN ** -0.5),
        'mla_w_down': nrm((N_MLA_LAYERS, D, MLA_Q_RANK + MLA_KV_RANK + MLA_ROPE), D ** -0.5),
        'mla_q_lora_norm': gain((N_MLA_LAYERS, MLA_Q_RANK)),
        'mla_kv_lora_norm': gain((N_MLA_LAYERS, MLA_KV_RANK)),
        'mla_w_uq': nrm((N_MLA_LAYERS, MLA_Q_RANK, MLA_HEADS * MLA_QK), MLA_Q_RANK ** -0.5),
        'mla_w_ukv': nrm((N_MLA_LAYERS, MLA_KV_RANK, MLA_HEADS * (MLA_NOPE + MLA_V)), MLA_KV_RANK ** -0.5),
        'mla_q_norm': gain((N_MLA_LAYERS, MLA_QK)),
        'mla_k_norm': gain((N_MLA_LAYERS, MLA_QK)),
        'mla_w_o': nrm((N_MLA_LAYERS, MLA_HEADS * MLA_V, D), (MLA_HEADS * MLA_V) ** -0.5),
        'gqa_w_qkv': nrm((N_GQA_LAYERS, D, (GQA_HEADS + 2 * GQA_KV_HEADS) * GQA_HEAD_DIM), D ** -0.5),
        'gqa_q_norm': gain((N_GQA_LAYERS, GQA_HEAD_DIM)),
        'gqa_k_norm': gain((N_GQA_LAYERS, GQA_HEAD_DIM)),
        'gqa_w_o': nrm((N_GQA_LAYERS, GQA_HEADS * GQA_HEAD_DIM, D), (GQA_HEADS * GQA_HEAD_DIM) ** -0.5),
        'na_w_qkv': nrm((N_NA_LAYERS, D, 3 * NA_HEADS * NA_HEAD_DIM), D ** -0.5),
        'na_q_norm': gain((N_NA_LAYERS, NA_HEAD_DIM)),
        'na_k_norm': gain((N_NA_LAYERS, NA_HEAD_DIM)),
        'na_rpb': nrm((N_NA_LAYERS, NA_HEADS, 2 * NA_WIN_ROWS - 1, 2 * NA_WIN_COLS - 1), 0.1),
        'na_w_o': nrm((N_NA_LAYERS, NA_HEADS * NA_HEAD_DIM, D), (NA_HEADS * NA_HEAD_DIM) ** -0.5),
        'ret_w_qkvg': nrm((N_RET_LAYERS, D, 2 * nk + 2 * nv), D ** -0.5),
        'ret_log_decay_fwd': base_decay * (1.0 + nrm((N_RET_LAYERS, RET_HEADS), 0.05)),
        'ret_log_decay_bwd': base_decay * (1.0 + nrm((N_RET_LAYERS, RET_HEADS), 0.05)),
        'ret_out_norm': gain((N_RET_LAYERS, nv)),
        'ret_w_o': nrm((N_RET_LAYERS, nv, D), nv ** -0.5),
    }


def reference(x, c, ctx, c_ctx, mod_w, mod_b, norm1, norm2, ffn_w13, ffn_w2,
              mla_w_down, mla_q_lora_norm, mla_kv_lora_norm, mla_w_uq, mla_w_ukv, mla_q_norm, mla_k_norm,
              mla_w_o, gqa_w_qkv, gqa_q_norm, gqa_k_norm, gqa_w_o,
              na_w_qkv, na_q_norm, na_k_norm, na_rpb, na_w_o,
              ret_w_qkvg, ret_log_decay_fwd, ret_log_decay_bwd, ret_out_norm, ret_w_o):
    h, hc = x, ctx
    silu_c = jax.nn.silu(c)
    silu_cc = jax.nn.silu(c_ctx)
    for i in range(DEPTH):
        need_ctx = i < DEPTH - 1
        ml = (silu_c @ mod_w[i] + mod_b[i])[:, None, :]
        mc = silu_cc @ mod_w[i] + mod_b[i]
        sh1, sc1, g1, sh2, sc2, g2 = jnp.split(ml, 6, axis=-1)
        csh1, csc1, cg1, csh2, csc2, cg2 = jnp.split(mc, 6)
        xl = rms_norm(h, norm1[i]) * (1.0 + sc1) + sh1
        xc = rms_norm(hc, norm1[i]) * (1.0 + csc1) + csh1
        kind, j = i % N_MIXERS, i // N_MIXERS
        if kind == 0:
            ol, oc = mla_mixer(xl, xc, mla_w_down[j], mla_q_lora_norm[j], mla_kv_lora_norm[j], mla_w_uq[j],
                               mla_w_ukv[j], mla_q_norm[j], mla_k_norm[j], mla_w_o[j], need_ctx)
        elif kind == 1:
            ol, oc = gqa_mixer(xl, xc, gqa_w_qkv[j], gqa_q_norm[j], gqa_k_norm[j], gqa_w_o[j], need_ctx)
        elif kind == 2:
            ol, oc = na_mixer(xl, xc, na_w_qkv[j], na_q_norm[j], na_k_norm[j], na_rpb[j], na_w_o[j], need_ctx)
        else:
            ol, oc = ret_mixer(xl, xc, ret_w_qkvg[j], ret_log_decay_fwd[j], ret_log_decay_bwd[j],
                               ret_out_norm[j], ret_w_o[j], need_ctx)
        h = h + g1 * ol
        h = h + g2 * swiglu(rms_norm(h, norm2[i]) * (1.0 + sc2) + sh2, ffn_w13[i], ffn_w2[i])
        if need_ctx:
            hc = hc + cg1 * oc
            hc = hc + cg2 * swiglu(rms_norm(hc, norm2[i]) * (1.0 + csc2) + csh2, ffn_w13[i], ffn_w2[i])
    return h
```

```cpp
#define BIGBK 64
#define BIGDIST 2
#include <hip/hip_runtime.h>
#include <hip/hip_cooperative_groups.h>
#include <cstdio>
namespace cg = cooperative_groups;

#define DI __device__ __forceinline__
typedef unsigned short u16;
typedef __attribute__((ext_vector_type(8))) short bf16x8;
typedef __attribute__((ext_vector_type(4))) short bf16x4;
typedef __attribute__((ext_vector_type(4))) float f32x4;
typedef __attribute__((ext_vector_type(16))) float f32x16;
typedef __attribute__((ext_vector_type(2))) float f32x2;
typedef __attribute__((ext_vector_type(4))) unsigned u32x4;
typedef __attribute__((ext_vector_type(2))) unsigned u32x2;
typedef __attribute__((ext_vector_type(2))) __bf16 bfv2;

constexpr int D = 1024, ML = 16384, MALL = 16896, TEXT = 8448, FH = 2816;
constexpr float LOG2E = 1.4426950408889634f;
constexpr float EPS = 1e-6f;
constexpr size_t W13T = 0, W2T = 5767168, MIX = 8650752;
constexpr size_t WT_ELEMS = MIX + 8388608;
constexpr int NPHASE = 37;
#ifndef BANDH
#define BANDH 16
#endif
#ifndef BIGBK
#define BIGBK 32
#define BIGDIST 3
#endif

struct Params {
  const float* in[32];
  float* out;
  float* modv;
  float2* tab;
  float* hctx;
  u16* wt;
  u16* xn;
  char* arena;
  unsigned* bar;
  int phase_lo, phase_hi;
};

#define PRM const __attribute__((address_space(4))) Params&
DI int get_tid() { int t = threadIdx.x; asm volatile("" : "+v"(t)); return t; }
DI int get_bid() { int b = blockIdx.x; asm volatile("" : "+s"(b)); return b; }
DI u16 f2bf(float x) { __bf16 b = (__bf16)x; return __builtin_bit_cast(u16, b); }
DI float bf2f(u16 v) { return __uint_as_float(((unsigned)v) << 16); }
DI unsigned pack2(float a, float b) { f32x2 f = {a, b}; bfv2 r = __builtin_convertvector(f, bfv2); return __builtin_bit_cast(unsigned, r); }
DI float wave_sum(float v) { for (int o = 32; o > 0; o >>= 1) v += __shfl_xor(v, o); return v; }
DI float silu(float x) { return x / (1.f + __expf(-x)); }
DI float ex2(float x) { return __builtin_amdgcn_exp2f(x); }
DI int clampi(int x, int lo, int hi) { return x < lo ? lo : (x > hi ? hi : x); }
DI int mod_idx(int m) { return m < 8192 ? 0 : (m < ML ? 1 : 2); }
DI void tok_bt(int m, int& b, int& t) { if (m < ML) { b = m >> 13; t = 256 + (m & 8191); } else { int c = m - ML; b = c >> 8; t = c & 255; } }
DI float* hrow(PRM p, int m) { return m < ML ? p.out + (size_t)m * D : p.hctx + (size_t)(m - ML) * D; }
#define MFMA16(a, b, c) __builtin_amdgcn_mfma_f32_16x16x32_bf16((a), (b), (c), 0, 0, 0)
#define MFMA32(a, b, c) __builtin_amdgcn_mfma_f32_32x32x16_bf16((a), (b), (c), 0, 0, 0)

DI int map_row(int mode, int n) {
  if (mode == 1) return n < FH ? 2 * n : 2 * (n - FH) + 1;
  if (mode == 2) { int h = n >> 8, c = n & 255; return c < 128 ? h * 128 + c : 1024 + h * 128 + (c - 128); }
  return n;
}
DI void convert_job(const float* src, int K, int N, int Npad, u16* dst, int mode, char* smem) {
  float* sT = (float*)smem;
  const int tid = get_tid();
  const int nkt = K >> 6, ntot = nkt * (Npad >> 6);
  for (int tile = get_bid(); tile < ntot; tile += gridDim.x) {
    const int k0 = (tile % nkt) * 64, n0 = (tile / nkt) * 64;
    __syncthreads();
#pragma unroll
    for (int i = 0; i < 4; ++i) {
      int r = (tid >> 4) + 16 * i, c4 = (tid & 15) * 4;
      float4 v = make_float4(0.f, 0.f, 0.f, 0.f);
      if (n0 + c4 < N) v = *(const float4*)(src + (size_t)(k0 + r) * N + n0 + c4);
      sT[r * 65 + c4] = v.x; sT[r * 65 + c4 + 1] = v.y; sT[r * 65 + c4 + 2] = v.z; sT[r * 65 + c4 + 3] = v.w;
    }
    __syncthreads();
#pragma unroll
    for (int i = 0; i < 2; ++i) {
      int c = tid + 256 * i, n = c >> 3, kc = c & 7;
      float f[8];
#pragma unroll
      for (int j = 0; j < 8; ++j) f[j] = sT[(kc * 8 + j) * 65 + n];
      uint4 pk = make_uint4(pack2(f[0], f[1]), pack2(f[2], f[3]), pack2(f[4], f[5]), pack2(f[6], f[7]));
      int nn = n0 + n;
      int row = nn < N ? map_row(mode, nn) : nn;
      *(uint4*)(dst + (size_t)row * K + k0 + kc * 8) = pk;
    }
  }
  __syncthreads();
}
DI void convert_layer(PRM p, int l, char* smem) {
  convert_job(p.in[8] + (size_t)l * 1024 * 5632, 1024, 5632, 5632, p.wt + W13T, 1, smem);
  convert_job(p.in[9] + (size_t)l * 2816 * 1024, 2816, 1024, 1024, p.wt + W2T, 0, smem);
  if (l == 0) {
    convert_job(p.in[10], 1024, 704, 768, p.wt + MIX, 0, smem);
    convert_job(p.in[13], 384, 1536, 1536, p.wt + MIX + 786432, 0, smem);
    convert_job(p.in[14], 256, 2048, 2048, p.wt + MIX + 786432 + 589824, 2, smem);
    convert_job(p.in[17], 1024, 1024, 1024, p.wt + MIX + 786432 + 589824 + 524288, 0, smem);
  } else if (l == 1) {
    convert_job(p.in[18], 1024, 1536, 1536, p.wt + MIX, 0, smem);
    convert_job(p.in[21], 1024, 1024, 1024, p.wt + MIX + 1572864, 0, smem);
  } else if (l == 2) {
    convert_job(p.in[22], 1024, 3072, 3072, p.wt + MIX, 0, smem);
    convert_job(p.in[26], 1024, 1024, 1024, p.wt + MIX + 3145728, 0, smem);
  } else {
    convert_job(p.in[27], 1024, 6144, 6144, p.wt + MIX, 0, smem);
    convert_job(p.in[31], 2048, 1024, 1024, p.wt + MIX + 6291456, 0, smem);
  }
}

DI void phase_init(PRM p, char* smem) {
  const int tid = get_tid(), lane = tid & 63, wave = tid >> 6;
  const size_t gtid = (size_t)get_bid() * 256 + tid, gstr = (size_t)gridDim.x * 256;
  {
    const float4* s2 = (const float4*)p.in[2]; float4* d2 = (float4*)p.hctx;
    for (size_t i = gtid; i < (size_t)512 * D / 4; i += gstr) d2[i] = s2[i];
  }
  for (size_t idx = gtid; idx < 128 * 112; idx += gstr) {
    int Qt, loc;
    if (idx < 2048) { Qt = 16; loc = (int)idx; } else if (idx < 6144) { Qt = 32; loc = (int)idx - 2048; } else { Qt = 64; loc = (int)idx - 6144; }
    int pos = loc / Qt, j = loc % Qt;
    float inv = exp2f(-(float)j / (float)Qt * 13.287712379549449f);
    float ang = (float)pos * inv;
    p.tab[idx] = make_float2(cosf(ang), sinf(ang));
  }
  {
    float* sc = (float*)smem;
    float* red = sc + 3 * 1024;
    if (get_bid() < 384) {
      for (int i = tid; i < 3072; i += 256) {
        int v = i >> 10, k = i & 1023;
        float x = v < 2 ? p.in[1][v * 1024 + k] : p.in[3][k];
        sc[i] = silu(x);
      }
    }
    __syncthreads();
    for (int cb = get_bid(); cb < 384; cb += gridDim.x) {
      int l = cb / 96, n = (cb % 96) * 64 + lane;
      const float* w = p.in[4] + (size_t)l * 1024 * 6144 + n;
      float a0 = 0.f, a1 = 0.f, a2 = 0.f;
      int kb = wave * 256;
#pragma unroll 8
      for (int k = 0; k < 256; ++k) {
        float wv = w[(size_t)(kb + k) * 6144];
        a0 += sc[kb + k] * wv; a1 += sc[1024 + kb + k] * wv; a2 += sc[2048 + kb + k] * wv;
      }
      red[(wave * 3 + 0) * 64 + lane] = a0; red[(wave * 3 + 1) * 64 + lane] = a1; red[(wave * 3 + 2) * 64 + lane] = a2;
      __syncthreads();
      if (tid < 192) {
        int v = tid >> 6;
        float s = red[(0 * 3 + v) * 64 + lane] + red[(1 * 3 + v) * 64 + lane] + red[(2 * 3 + v) * 64 + lane] + red[(3 * 3 + v) * 64 + lane];
        p.modv[(size_t)(l * 3 + v) * 6144 + n] = s + p.in[5][l * 6144 + n];
      }
      __syncthreads();
    }
  }
  convert_layer(p, 0, smem);
}

DI void phase_norm(PRM p, int l, int which, int Mrows) {
  const int lane = get_tid() & 63, wave = get_tid() >> 6;
  const float* gain = p.in[which ? 7 : 6] + l * D;
  const int sc_off = which ? 4 * D : D, sh_off = which ? 3 * D : 0;
  const int stride = gridDim.x * 4;
  for (int m0 = get_bid() * 4 + wave; m0 < Mrows; m0 += 4 * stride) {
    float4 v[4][4]; float ss[4];
#pragma unroll
    for (int k = 0; k < 4; ++k) {
      const int m = m0 + k * stride;
      ss[k] = 0.f;
      if (m < Mrows) {
        const float* h = (l == 0 && which == 0 && m < ML) ? p.in[0] + (size_t)m * D : hrow(p, m);
#pragma unroll
        for (int i = 0; i < 4; ++i) v[k][i] = *(const float4*)(h + i * 256 + lane * 4);
      } else {
#pragma unroll
        for (int i = 0; i < 4; ++i) v[k][i] = make_float4(0.f, 0.f, 0.f, 0.f);
      }
    }
#pragma unroll
    for (int k = 0; k < 4; ++k) {
#pragma unroll
      for (int i = 0; i < 4; ++i) ss[k] += v[k][i].x * v[k][i].x + v[k][i].y * v[k][i].y + v[k][i].z * v[k][i].z + v[k][i].w * v[k][i].w;
      ss[k] = wave_sum(ss[k]);
    }
#pragma unroll
    for (int k = 0; k < 4; ++k) {
      const int m = m0 + k * stride;
      if (m < Mrows) {
        const float* mv = p.modv + (size_t)(l * 3 + mod_idx(m)) * 6144;
        const float r = rsqrtf(ss[k] * (1.f / 1024.f) + EPS);
#pragma unroll
        for (int i = 0; i < 4; ++i) {
          int c = i * 256 + lane * 4;
          float4 g = *(const float4*)(gain + c), sc = *(const float4*)(mv + sc_off + c), sh = *(const float4*)(mv + sh_off + c);
          float y0 = v[k][i].x * r * g.x * (1.f + sc.x) + sh.x, y1 = v[k][i].y * r * g.y * (1.f + sc.y) + sh.y;
          float y2 = v[k][i].z * r * g.z * (1.f + sc.z) + sh.z, y3 = v[k][i].w * r * g.w * (1.f + sc.w) + sh.w;
          *(uint2*)(p.xn + (size_t)m * D + c) = make_uint2(pack2(y0, y1), pack2(y2, y3));
        }
      }
    }
  }
}

enum { EPI_STORE = 0, EPI_VT = 1, EPI_RESID = 2, EPI_SWIGLU = 3, EPI_RETP = 4 };
struct GJob { const u16* P; const u16* Q; int ldp, ldq, K, nI, nJ, epi; u16* o; int ld, a, b; };

DI GJob mkjob(const u16* P, int ldp, const u16* Q, int ldq, int K, int nI, int nJ, int epi, u16* o, int ld, int a, int b) {
  GJob J; J.P = P; J.Q = Q; J.ldp = ldp; J.ldq = ldq; J.K = K; J.nI = nI; J.nJ = nJ; J.epi = epi; J.o = o; J.ld = ld; J.a = a; J.b = b; return J;
}
constexpr size_t A0_RAW1 = 0, A0_CQN = 25952256, A0_CKVN = A0_CQN + 12976128, A0_QRAW = A0_CKVN + 8650752, A0_KNRAW = A0_QRAW + 51904512,
                 A0_Q = A0_KNRAW + 34603008, A0_K = A0_Q + 51904512, A0_VT = A0_K + 51904512, A0_O = A0_QRAW;
constexpr size_t A1_RAW = 0, A1_Q = 43253760, A1_K = A1_Q + 34603008, A1_VT = A1_K + 8650752, A1_O = A1_VT + 8650752;
constexpr size_t A2_RAW = 0, A2_Q = 69206016, A2_K = A2_Q + 34603008, A2_VT = A2_K + 34603008, A2_O = A2_VT + 34603008;
constexpr size_t A3_RAW = 0, A3_Y = 0, A3_VT = 69206016, A3_U = A3_VT, A3_G = A3_VT + 69206016, A3_KN = A3_G + 67108864, A3_KT = A3_KN + 33554432,
                 A3_P = A3_KT + 34603008, A3_END = A3_P + 33554432;
constexpr size_t ARENA_BYTES = A3_END;

DI GJob make_job(PRM p, int ph, int jj) {
  u16* ar = (u16*)p.arena;
  const u16* wt = p.wt;
  GJob Z = mkjob(nullptr, 0, nullptr, 0, 0, 0, 0, 0, nullptr, 0, 0, 0);
  switch (ph) {
    case 2: if (jj == 0) return mkjob(wt + MIX, 1024, p.xn, 1024, 1024, 3, 132, EPI_STORE, (u16*)(p.arena + A0_RAW1), 768, 768, 0); break;
    case 4:
      if (jj == 0) return mkjob(wt + MIX + 786432, 384, (u16*)(p.arena + A0_CQN), 384, 384, 6, 132, EPI_STORE, (u16*)(p.arena + A0_QRAW), 1536, 1536, 0);
      if (jj == 1) return mkjob(wt + MIX + 786432 + 589824, 256, (u16*)(p.arena + A0_CKVN), 256, 256, 4, 132, EPI_STORE, (u16*)(p.arena + A0_KNRAW), 1024, 1024, 0);
      if (jj == 2) return mkjob((u16*)(p.arena + A0_CKVN), 256, wt + MIX + 786432 + 589824 + 1024 * 256, 256, 256, 66, 8, EPI_VT, (u16*)(p.arena + A0_VT), 0, 7, 8);
      break;
    case 7: if (jj == 0) return mkjob(wt + MIX + 786432 + 589824 + 524288, 1024, (u16*)(p.arena + A0_O), 1024, 1024, 8, 176, EPI_RESID, nullptr, 0, 0, 2 * D); break;
    case 12:
      if (jj == 0) return mkjob(wt + MIX, 1024, p.xn, 1024, 1024, 5, 132, EPI_STORE, (u16*)(p.arena + A1_RAW), 1280, 1280, 0);
      if (jj == 1) return mkjob(p.xn, 1024, wt + MIX + 1280 * 1024, 1024, 1024, 66, 2, EPI_VT, (u16*)(p.arena + A1_VT), 0, 7, 2);
      break;
    case 15: if (jj == 0) return mkjob(wt + MIX + 1572864, 1024, (u16*)(p.arena + A1_O), 1024, 1024, 8, 176, EPI_RESID, nullptr, 0, 1, 2 * D); break;
    case 20:
      if (jj == 0) return mkjob(wt + MIX, 1024, p.xn, 1024, 1024, 8, 132, EPI_STORE, (u16*)(p.arena + A2_RAW), 2048, 2048, 0);
      if (jj == 1) return mkjob(p.xn, 1024, wt + MIX + 2048 * 1024, 1024, 1024, 66, 8, EPI_VT, (u16*)(p.arena + A2_VT), 0, 6, 16);
      break;
    case 23: if (jj == 0) return mkjob(wt + MIX + 3145728, 1024, (u16*)(p.arena + A2_O), 1024, 1024, 8, 176, EPI_RESID, nullptr, 0, 2, 2 * D); break;
    case 28:
      if (jj == 0) return mkjob(wt + MIX, 1024, p.xn, 1024, 1024, 8, 132, EPI_STORE, (u16*)(p.arena + A3_RAW), 2048, 2048, 0);
      if (jj == 1) return mkjob(p.xn, 1024, wt + MIX + 2048 * 1024, 1024, 1024, 66, 16, EPI_VT, (u16*)(p.arena + A3_VT), 0, 9, 4);
      if (jj == 2) return mkjob(wt + MIX + 4096 * 1024, 1024, p.xn, 1024, 1024, 8, 128, EPI_STORE, (u16*)(p.arena + A3_G), 2048, 2048, 0);
      break;
    case 30: if (jj == 0) return mkjob((u16*)(p.arena + A3_KN), 1024, p.xn, 1024, 256, 512, 1, EPI_RETP, (u16*)(p.arena + A3_P), 0, 0, 0); break;
    case 33: if (jj == 0) return mkjob(wt + MIX + 6291456, 2048, (u16*)(p.arena + A3_U), 2048, 2048, 8, 176, EPI_RESID, nullptr, 0, 3, 2 * D); break;
    case 9: case 17: case 25: case 35:
      if (jj == 0) return mkjob(wt + W13T, 1024, p.xn, 1024, 1024, 22, 132, EPI_SWIGLU, ar, 0, 0, 0);
      break;
    case 10: case 18: case 26: case 36:
      if (jj == 0) return mkjob(wt + W2T, 2816, ar, 2816, 2816, 8, 176, EPI_RESID, nullptr, 0, (ph - 10) / 8 + (ph == 36 ? 0 : 0), 5 * D);
      break;
    default: break;
  }
  return Z;
}

template <int MT, int NT, int BK, int DIST>
DI void gemm_core(PRM p, const GJob& J, const u16* Pb, const u16* Qb, int i0, int j0, int aux, char* smem) {
  constexpr int LS = BK + 16, CPR = BK / 8;
  constexpr int RPI = 256 / CPR, NP = MT * 32 / RPI, NQ = NT * 32 / RPI, KS = BK / 32;
  const int tid = get_tid(), lane = tid & 63, wave = tid >> 6, wi = wave >> 1, wj = wave & 1, fr = lane & 15, fq = lane >> 4;
  u16* sP = (u16*)smem; u16* sQ = sP + MT * 32 * LS;
  f32x4 acc[MT][NT];
#pragma unroll
  for (int a = 0; a < MT; ++a)
#pragma unroll
    for (int b = 0; b < NT; ++b) acc[a][b] = (f32x4){0.f, 0.f, 0.f, 0.f};
  const u16* gpb = Pb + (size_t)i0 * J.ldp;
  const u16* gqb = Qb + (size_t)j0 * J.ldq;
  const unsigned po = (tid / CPR) * J.ldp + (tid % CPR) * 8, qo = (tid / CPR) * J.ldq + (tid % CPR) * 8;
  const unsigned spr = RPI * J.ldp, sqr = RPI * J.ldq;
  u32x4 rp[NP], rq[NQ];
#pragma unroll
  for (int i = 0; i < NP; ++i) rp[i] = *(const u32x4*)(gpb + (po + spr * i));
#pragma unroll
  for (int i = 0; i < NQ; ++i) rq[i] = *(const u32x4*)(gqb + (qo + sqr * i));
  const int nk = J.K / BK;
  const int so = (tid / CPR) * LS + (tid % CPR) * 8;
  for (int kt = 0; kt < nk; ++kt) {
    __syncthreads();
#pragma unroll
    for (int i = 0; i < NP; ++i) *(u32x4*)(sP + so + RPI * LS * i) = rp[i];
#pragma unroll
    for (int i = 0; i < NQ; ++i) *(u32x4*)(sQ + so + RPI * LS * i) = rq[i];
    __syncthreads();
    if (kt + 1 < nk) {
#pragma unroll
      for (int i = 0; i < NP; ++i) rp[i] = *(const u32x4*)(gpb + (po + spr * i + (kt + 1) * BK));
#pragma unroll
      for (int i = 0; i < NQ; ++i) rq[i] = *(const u32x4*)(gqb + (qo + sqr * i + (kt + 1) * BK));
    }
#pragma unroll
    for (int ks = 0; ks < KS; ++ks) {
      bf16x8 b[NT], a[MT];
#pragma unroll
      for (int nj = 0; nj < NT; ++nj) b[nj] = *(const bf16x8*)(sQ + (wj * NT * 16 + nj * 16 + fr) * LS + ks * 32 + fq * 8);
#define LDA(m) (*(const bf16x8*)(sP + (wi * MT * 16 + (m) * 16 + fr) * LS + ks * 32 + fq * 8))
#pragma unroll
      for (int m = 0; m < DIST; ++m) a[m] = LDA(m);
      __builtin_amdgcn_sched_barrier(0);
#pragma unroll
      for (int mi = 0; mi < MT; ++mi) {
        if (mi + DIST < MT) a[mi + DIST] = LDA(mi + DIST);
#pragma unroll
        for (int nj = 0; nj < NT; ++nj) acc[mi][nj] = MFMA16(a[mi], b[nj], acc[mi][nj]);
        __builtin_amdgcn_sched_barrier(0);
      }
#undef LDA
    }
  }
  if (MT == 8 && J.epi == EPI_SWIGLU) {
    u16* sO = (u16*)smem;
    __syncthreads();
#pragma unroll
    for (int mi = 0; mi < MT; ++mi)
#pragma unroll
      for (int nj = 0; nj < NT; ++nj) {
        const int ul = (wi * MT * 16 + mi * 16 + fq * 4) >> 1, jl = wj * NT * 16 + nj * 16 + fr;
        const f32x4 v = acc[mi][nj];
        *(unsigned*)(sO + jl * 136 + ul) = pack2(silu(v[0]) * v[1], silu(v[2]) * v[3]);
      }
    __syncthreads();
    const int row = tid >> 1, half = tid & 1;
    u16* dst = J.o + (size_t)(j0 + row) * FH + (i0 >> 1) + half * 64;
#pragma unroll
    for (int c = 0; c < 8; ++c) *(u32x4*)(dst + c * 8) = *(const u32x4*)(sO + row * 136 + half * 64 + c * 8);
    return;
  }
  if (NT == 3 && J.epi == EPI_RESID) {
    float* sO = (float*)smem;
    __syncthreads();
#pragma unroll
    for (int mi = 0; mi < MT; ++mi)
#pragma unroll
      for (int nj = 0; nj < NT; ++nj) {
        const int il = wi * MT * 16 + mi * 16 + fq * 4, jl = wj * NT * 16 + nj * 16 + fr;
        *(f32x4*)(sO + jl * 132 + il) = acc[mi][nj];
      }
    __syncthreads();
#pragma unroll
    for (int k = 0; k < 12; ++k) {
      const int c = tid + 256 * k, row = c >> 5, ch = c & 31, j = j0 + row, i = i0 + ch * 4;
      const f32x4 v = *(const f32x4*)(sO + row * 132 + ch * 4);
      float* hp = hrow(p, j) + i;
      const float* hin = (J.a == 0 && J.b == 2 * D && j < ML) ? p.in[0] + (size_t)j * D + i : hp;
      const float4 g = *(const float4*)(p.modv + (size_t)(J.a * 3 + mod_idx(j)) * 6144 + J.b + i);
      float4 hv = *(const float4*)hin;
      hv.x += g.x * v[0]; hv.y += g.y * v[1]; hv.z += g.z * v[2]; hv.w += g.w * v[3];
      *(float4*)hp = hv;
    }
    return;
  }
  float ldf2 = 0.f, ldb2 = 0.f;
  if (J.epi == EPI_RETP) { int h = (aux >> 6) & 3; ldf2 = p.in[28][h] * LOG2E; ldb2 = p.in[29][h] * LOG2E; }
#pragma unroll
  for (int mi = 0; mi < MT; ++mi)
#pragma unroll
    for (int nj = 0; nj < NT; ++nj) {
      const int i = i0 + wi * MT * 16 + mi * 16 + fq * 4, j = j0 + wj * NT * 16 + nj * 16 + fr;
      const f32x4 v = acc[mi][nj];
      if (J.epi == EPI_STORE) {
        if (i < J.a) *(uint2*)(J.o + (size_t)j * J.ld + i) = make_uint2(pack2(v[0], v[1]), pack2(v[2], v[3]));
      } else if (J.epi == EPI_VT) {
        int b, t; tok_bt(i, b, t);
        int hh = j >> J.a, dv = j & ((1 << J.a) - 1);
        *(uint2*)(J.o + ((size_t)((b * J.b + hh) << J.a) + dv) * TEXT + t) = make_uint2(pack2(v[0], v[1]), pack2(v[2], v[3]));
      } else if (J.epi == EPI_RESID) {
        float* hp = hrow(p, j) + i;
        const float4 g = *(const float4*)(p.modv + (size_t)(J.a * 3 + mod_idx(j)) * 6144 + J.b + i);
        float4 hv = *(float4*)hp;
        hv.x += g.x * v[0]; hv.y += g.y * v[1]; hv.z += g.z * v[2]; hv.w += g.w * v[3];
        *(float4*)hp = hv;
      } else if (J.epi == EPI_SWIGLU) {
        *(unsigned*)(J.o + (size_t)j * FH + (i >> 1)) = pack2(silu(v[0]) * v[1], silu(v[2]) * v[3]);
      } else {
        float pf[4], pb[4];
#pragma unroll
        for (int r = 0; r < 4; ++r) {
          int t = i + r, d = j - t;
          pf[r] = d >= 0 ? v[r] * ex2((float)d * ldf2) : 0.f;
          pb[r] = d <= 0 ? v[r] * ex2((float)(-d) * ldb2) : 0.f;
        }
        size_t off = ((size_t)aux * 128 + j) * 128 + i;
        *(uint2*)(J.o + off) = make_uint2(pack2(pf[0], pf[1]), pack2(pf[2], pf[3]));
        *(uint2*)(J.o + (size_t)512 * 128 * 128 + off) = make_uint2(pack2(pb[0], pb[1]), pack2(pb[2], pb[3]));
      }
    }
}

DI void gemm_phase(PRM p, int ph, char* smem) {
  int total = 0;
  for (int jj = 0; jj < 3; ++jj) { GJob J = make_job(p, ph, jj); total += J.nI * J.nJ; }
  const int G = gridDim.x, G8 = G >> 3, bid = get_bid();
  const int nround = (total + G - 1) / G;
  for (int r = 0; r < nround; ++r) {
    const int L = (r * 8 + (bid & 7)) * G8 + (bid >> 3);
    if (L >= total) continue;
    int t = L, jj = 0;
    GJob J = make_job(p, ph, 0);
    while (t >= J.nI * J.nJ) { t -= J.nI * J.nJ; ++jj; J = make_job(p, ph, jj); }
    if (J.epi == EPI_RETP) {
      int bh = t >> 6, chunk = t & 63, b = bh >> 2, h = bh & 3;
      size_t off = (size_t)(b * 8192 + chunk * 128) * 1024 + h * 256;
      gemm_core<4, 4, 64, 2>(p, J, J.P + off, J.Q + off, 0, 0, t, smem);
    } else {
      const int band = t / (BANDH * J.nI), rr = t % (BANDH * J.nI);
      const int hgt = min(BANDH, J.nJ - band * BANDH);
      const int ti = rr / hgt, tj = band * BANDH + rr % hgt;
      if (J.epi == EPI_RESID) gemm_core<4, 3, 64, 2>(p, J, J.P, J.Q, ti * 128, tj * 96, 0, smem);
      else gemm_core<8, 4, BIGBK, BIGDIST>(p, J, J.P, J.Q, ti * 256, tj * 128, 0, smem);
    }
  }
}

DI void phase_mla_post1(PRM p) {
  const int lane = get_tid() & 63, wave = get_tid() >> 6;
  const u16* raw = (const u16*)(p.arena + A0_RAW1);
  u16* cqn = (u16*)(p.arena + A0_CQN); u16* ckvn = (u16*)(p.arena + A0_CKVN);
  for (int m = get_bid() * 4 + wave; m < MALL; m += gridDim.x * 4) {
    const u16* r = raw + (size_t)m * 768;
    float q[6], k[4], sq = 0.f, sk = 0.f;
#pragma unroll
    for (int i = 0; i < 6; ++i) { q[i] = bf2f(r[lane + 64 * i]); sq += q[i] * q[i]; }
#pragma unroll
    for (int i = 0; i < 4; ++i) { k[i] = bf2f(r[384 + lane + 64 * i]); sk += k[i] * k[i]; }
    sq = wave_sum(sq); sk = wave_sum(sk);
    float rq = rsqrtf(sq * (1.f / 384.f) + EPS), rk = rsqrtf(sk * (1.f / 256.f) + EPS);
#pragma unroll
    for (int i = 0; i < 6; ++i) cqn[(size_t)m * 384 + lane + 64 * i] = f2bf(q[i] * rq * p.in[11][lane + 64 * i]);
#pragma unroll
    for (int i = 0; i < 4; ++i) ckvn[(size_t)m * 256 + lane + 64 * i] = f2bf(k[i] * rk * p.in[12][lane + 64 * i]);
  }
}
DI void phase_mla_post2(PRM p) {
  const int lane = get_tid() & 63, wave = get_tid() >> 6;
  const u16* raw1 = (const u16*)(p.arena + A0_RAW1);
  const u16* qraw = (const u16*)(p.arena + A0_QRAW);
  const u16* knraw = (const u16*)(p.arena + A0_KNRAW);
  u16* Qf = (u16*)(p.arena + A0_Q); u16* Kf = (u16*)(p.arena + A0_K);
  const int nitems = MALL * 16, stride = gridDim.x * 4;
  const float gq0 = p.in[15][lane], gq1 = p.in[15][lane + 64], gq2 = p.in[15][lane + 128];
  const float gk0 = p.in[16][lane], gk1 = p.in[16][lane + 64], gk2 = p.in[16][lane + 128];
  for (int it0 = get_bid() * 4 + wave; it0 < nitems; it0 += 4 * stride) {
    u16 rv[4][3];
#pragma unroll
    for (int u = 0; u < 4; ++u) {
      const int it = it0 + u * stride;
      rv[u][0] = rv[u][1] = rv[u][2] = 0;
      if (it < nitems) {
        const int m = it >> 4, hh = it & 15, isk = hh >> 3, h = hh & 7;
        if (!isk) {
          const u16* s = qraw + (size_t)m * 1536 + h * 192;
          rv[u][0] = s[lane]; rv[u][1] = s[lane + 64]; rv[u][2] = s[lane + 128];
        } else {
          const u16* s = knraw + (size_t)m * 1024 + h * 128;
          rv[u][0] = s[lane]; rv[u][1] = s[lane + 64]; rv[u][2] = raw1[(size_t)m * 768 + 640 + lane];
        }
      }
    }
#pragma unroll
    for (int u = 0; u < 4; ++u) {
      const int it = it0 + u * stride;
      if (it < nitems) {
        const int m = it >> 4, hh = it & 15, isk = hh >> 3, h = hh & 7;
        float v0 = bf2f(rv[u][0]), v1 = bf2f(rv[u][1]), v2 = bf2f(rv[u][2]);
        float ss = wave_sum(v0 * v0 + v1 * v1 + v2 * v2);
        float r = rsqrtf(ss * (1.f / 192.f) + EPS);
        v0 *= r * (isk ? gk0 : gq0); v1 *= r * (isk ? gk1 : gq1); v2 *= r * (isk ? gk2 : gq2);
        float partner = __shfl_xor(v2, 32);
        if (m < ML) {
          int sq = m & 8191, pr = lane & 31;
          int pos = pr < 16 ? (sq >> 6) : (sq & 63);
          float2 cs = p.tab[pos * 16 + (pr & 15)];
          v2 = lane < 32 ? v2 * cs.x - partner * cs.y : partner * cs.y + v2 * cs.x;
        }
        u16* d;
        if (!isk) d = Qf + (size_t)m * 1536 + h * 192;
        else { int b, t; tok_bt(m, b, t); d = Kf + ((size_t)(b * 8 + h) * TEXT + t) * 192; }
        d[lane] = f2bf(v0); d[lane + 64] = f2bf(v1); d[lane + 128] = f2bf(v2);
      }
    }
  }
}
DI void phase_gqa_post(PRM p) {
  const int lane = get_tid() & 63, wave = get_tid() >> 6;
  const u16* raw = (const u16*)(p.arena + A1_RAW);
  u16* Qf = (u16*)(p.arena + A1_Q); u16* Kf = (u16*)(p.arena + A1_K);
  const int nitems = MALL * 10, stride = gridDim.x * 4;
  const float gq0 = p.in[19][lane], gq1 = p.in[19][lane + 64], gk0 = p.in[20][lane], gk1 = p.in[20][lane + 64];
  for (int it0 = get_bid() * 4 + wave; it0 < nitems; it0 += 4 * stride) {
    u16 rv[4][2];
#pragma unroll
    for (int u = 0; u < 4; ++u) {
      const int it = it0 + u * stride;
      rv[u][0] = rv[u][1] = 0;
      if (it < nitems) {
        const int m = it / 10, hh = it % 10;
        const u16* s = raw + (size_t)m * 1280 + hh * 128;
        rv[u][0] = s[lane]; rv[u][1] = s[lane + 64];
      }
    }
#pragma unroll
    for (int u = 0; u < 4; ++u) {
      const int it = it0 + u * stride;
      if (it < nitems) {
        const int m = it / 10, hh = it % 10, isk = hh >= 8;
        float x1 = bf2f(rv[u][0]), x2 = bf2f(rv[u][1]);
        float ss = wave_sum(x1 * x1 + x2 * x2);
        float r = rsqrtf(ss * (1.f / 128.f) + EPS);
        x1 *= r * (isk ? gk0 : gq0); x2 *= r * (isk ? gk1 : gq1);
        if (m < ML) {
          int sq = m & 8191;
          int pos = lane < 32 ? (sq >> 6) : (sq & 63);
          float2 cs = p.tab[2048 + pos * 32 + (lane & 31)];
          float y1 = x1 * cs.x - x2 * cs.y, y2 = x1 * cs.y + x2 * cs.x;
          x1 = y1; x2 = y2;
        }
        u16* d;
        if (!isk) d = Qf + (size_t)m * 1024 + hh * 128;
        else { int b, t; tok_bt(m, b, t); d = Kf + ((size_t)(b * 2 + (hh - 8)) * TEXT + t) * 128; }
        d[lane] = f2bf(x1); d[lane + 64] = f2bf(x2);
      }
    }
  }
}
DI void phase_na_post(PRM p) {
  const int lane = get_tid() & 63, wave = get_tid() >> 6;
  const u16* raw = (const u16*)(p.arena + A2_RAW);
  u16* Qf = (u16*)(p.arena + A2_Q); u16* Kf = (u16*)(p.arena + A2_K);
  const int stride = gridDim.x * 4;
  float gq[8], gk[8];
#pragma unroll
  for (int j = 0; j < 8; ++j) { gq[j] = p.in[23][(lane & 7) * 8 + j]; gk[j] = p.in[24][(lane & 7) * 8 + j]; }
  for (int m = get_bid() * 4 + wave; m < MALL; m += stride) {
    u32x4 rv[4];
#pragma unroll
    for (int ps = 0; ps < 4; ++ps) rv[ps] = *(const u32x4*)(raw + (size_t)m * 2048 + ps * 512 + lane * 8);
    int b, t; tok_bt(m, b, t);
#pragma unroll
    for (int ps = 0; ps < 4; ++ps) {
      float f[8]; float ss = 0.f;
#pragma unroll
      for (int j = 0; j < 4; ++j) { f[2 * j] = __uint_as_float(rv[ps][j] << 16); f[2 * j + 1] = __uint_as_float(rv[ps][j] & 0xffff0000u); }
#pragma unroll
      for (int j = 0; j < 8; ++j) ss += f[j] * f[j];
      ss += __shfl_xor(ss, 1); ss += __shfl_xor(ss, 2); ss += __shfl_xor(ss, 4);
      const float r = rsqrtf(ss * (1.f / 64.f) + EPS);
      const bool isk = ps >= 2;
      unsigned w[4];
#pragma unroll
      for (int j = 0; j < 4; ++j) w[j] = pack2(f[2 * j] * r * (isk ? gk[2 * j] : gq[2 * j]), f[2 * j + 1] * r * (isk ? gk[2 * j + 1] : gq[2 * j + 1]));
      const int e = (ps & 1) * 512 + lane * 8, h = e >> 6;
      u16* d = isk ? Kf + ((size_t)(b * 16 + h) * TEXT + t) * 64 + (e & 63) : Qf + (size_t)m * 1024 + e;
      *(u32x4*)d = (u32x4){w[0], w[1], w[2], w[3]};
    }
  }
}
DI void phase_ret_post(PRM p, char* smem) {
  const int tid = get_tid(), lane = tid & 63, wave = tid >> 6;
  const u16* raw = (const u16*)(p.arena + A3_RAW);
  u16* Qf = p.xn; u16* Kn = (u16*)(p.arena + A3_KN); u16* KT = (u16*)(p.arena + A3_KT);
  {
    const int stride = gridDim.x * 4, nitems = ML * 4;
    for (int it0 = get_bid() * 4 + wave; it0 < nitems; it0 += 4 * stride) {
      u16 rv[4][4];
#pragma unroll
      for (int k = 0; k < 4; ++k) {
        const int it = it0 + k * stride;
        rv[k][0] = rv[k][1] = rv[k][2] = rv[k][3] = 0;
        if (it < nitems) {
          const u16* s = raw + (size_t)(it >> 2) * 2048 + (it & 3) * 256;
          rv[k][0] = s[lane]; rv[k][1] = s[lane + 64]; rv[k][2] = s[lane + 128]; rv[k][3] = s[lane + 192];
        }
      }
#pragma unroll
      for (int k = 0; k < 4; ++k) {
        const int it = it0 + k * stride;
        if (it < nitems) {
          const int m = it >> 2, h = it & 3, sq = m & 8191;
          float a1 = bf2f(rv[k][0]), b1 = bf2f(rv[k][1]), a2 = bf2f(rv[k][2]), b2 = bf2f(rv[k][3]);
          float2 ca = p.tab[6144 + (sq >> 6) * 64 + lane], cb = p.tab[6144 + (sq & 63) * 64 + lane];
          u16* d = Qf + (size_t)m * 1024 + h * 256;
          d[lane] = f2bf(a1 * ca.x - a2 * ca.y); d[lane + 128] = f2bf(a1 * ca.y + a2 * ca.x);
          d[lane + 64] = f2bf(b1 * cb.x - b2 * cb.y); d[lane + 192] = f2bf(b1 * cb.y + b2 * cb.x);
        }
      }
    }
  }
  u16* sT = (u16*)smem;
  for (int it = get_bid(); it < 264 * 4; it += gridDim.x) {
    const int tb = it >> 2, h = it & 3, m0 = tb * 64;
    __syncthreads();
    for (int t4 = 0; t4 < 16; t4 += 4) {
      u16 rv[4][4];
#pragma unroll
      for (int k = 0; k < 4; ++k) {
        const u16* s = raw + (size_t)(m0 + wave * 16 + t4 + k) * 2048 + 1024 + h * 256;
        rv[k][0] = s[lane]; rv[k][1] = s[lane + 64]; rv[k][2] = s[lane + 128]; rv[k][3] = s[lane + 192];
      }
#pragma unroll
      for (int k = 0; k < 4; ++k) {
        const int tl = wave * 16 + t4 + k, m = m0 + tl;
        float a1 = bf2f(rv[k][0]) * 0.0625f, b1 = bf2f(rv[k][1]) * 0.0625f, a2 = bf2f(rv[k][2]) * 0.0625f, b2 = bf2f(rv[k][3]) * 0.0625f;
        if (m < ML) {
          int sq = m & 8191;
          float2 ca = p.tab[6144 + (sq >> 6) * 64 + lane], cb = p.tab[6144 + (sq & 63) * 64 + lane];
          float y1 = a1 * ca.x - a2 * ca.y, y2 = a1 * ca.y + a2 * ca.x, z1 = b1 * cb.x - b2 * cb.y, z2 = b1 * cb.y + b2 * cb.x;
          a1 = y1; a2 = y2; b1 = z1; b2 = z2;
        }
        u16 o0 = f2bf(a1), o1 = f2bf(b1), o2 = f2bf(a2), o3 = f2bf(b2);
        if (m < ML) { u16* d = Kn + (size_t)m * 1024 + h * 256; d[lane] = o0; d[lane + 64] = o1; d[lane + 128] = o2; d[lane + 192] = o3; }
        u16* r = sT + tl * 258; r[lane] = o0; r[lane + 64] = o1; r[lane + 128] = o2; r[lane + 192] = o3;
      }
    }
    __syncthreads();
    int b, t0; tok_bt(m0, b, t0);
#pragma unroll
    for (int i = 0; i < 8; ++i) {
      int c = tid + 256 * i, k = c & 255, tc = c >> 8;
      u16 e[8];
#pragma unroll
      for (int j = 0; j < 8; ++j) e[j] = sT[(tc * 8 + j) * 258 + k];
      uint4 pk = make_uint4(e[0] | ((unsigned)e[1] << 16), e[2] | ((unsigned)e[3] << 16), e[4] | ((unsigned)e[5] << 16), e[6] | ((unsigned)e[7] << 16));
      *(uint4*)(KT + ((size_t)((b * 4 + h) * 256 + k)) * TEXT + t0 + tc * 8) = pk;
    }
  }
  __syncthreads();
}
DI void phase_ret_gate(PRM p) {
  const int lane = get_tid() & 63, wave = get_tid() >> 6;
  const u16* y = (const u16*)(p.arena + A3_Y); const u16* g = (const u16*)(p.arena + A3_G); u16* u = (u16*)(p.arena + A3_U);
  const int stride = gridDim.x * 4, nitems = ML * 4;
  for (int it0 = get_bid() * 4 + wave; it0 < nitems; it0 += 4 * stride) {
    u32x4 yv[4], gv[4];
#pragma unroll
    for (int k = 0; k < 4; ++k) {
      const int it = it0 + k * stride;
      yv[k] = (u32x4){0u, 0u, 0u, 0u}; gv[k] = yv[k];
      if (it < nitems) {
        const size_t off = (size_t)(it >> 2) * 2048 + (it & 3) * 512 + lane * 8;
        yv[k] = *(const u32x4*)(y + off); gv[k] = *(const u32x4*)(g + off);
      }
    }
#pragma unroll
    for (int k = 0; k < 4; ++k) {
      const int it = it0 + k * stride;
      if (it < nitems) {
        const int h = it & 3;
        const size_t off = (size_t)(it >> 2) * 2048 + h * 512 + lane * 8;
        float f[8], gg[8], s = 0.f;
#pragma unroll
        for (int i = 0; i < 4; ++i) {
          f[2 * i] = __uint_as_float(yv[k][i] << 16); f[2 * i + 1] = __uint_as_float(yv[k][i] & 0xffff0000u);
          gg[2 * i] = __uint_as_float(gv[k][i] << 16); gg[2 * i + 1] = __uint_as_float(gv[k][i] & 0xffff0000u);
        }
#pragma unroll
        for (int i = 0; i < 8; ++i) s += f[i];
        float mu = wave_sum(s) * (1.f / 512.f), vs = 0.f;
#pragma unroll
        for (int i = 0; i < 8; ++i) { f[i] -= mu; vs += f[i] * f[i]; }
        float r = rsqrtf(wave_sum(vs) * (1.f / 512.f) + EPS);
        const float* on = p.in[30] + h * 512 + lane * 8;
        float o[8];
#pragma unroll
        for (int i = 0; i < 8; ++i) o[i] = f[i] * r * on[i] * silu(gg[i]);
        *(u32x4*)(u + off) = (u32x4){pack2(o[0], o[1]), pack2(o[2], o[3]), pack2(o[4], o[5]), pack2(o[6], o[7])};
      }
    }
  }
}

template <int DQK, int DV, bool NA, int KT>
DI void attn_phase(PRM p, const u16* Qf, const u16* Kf, const u16* VT, u16* O, int H, int KVH, float scale, const float* rpb,
                   bool do_lat, bool do_ctx, char* smem) {
  constexpr int KST = DQK + 8, VST = KT + 4, NKC = KT * DQK / 2048, NVC = DV * KT / 2048, KCH = DQK / 8, VCH = KT / 8, NKB = KT / 32, KR = KCH / 8, NDVB = DV / 32;
  const int tid = get_tid(), lane = tid & 63, wave = tid >> 6, hh = lane >> 5, ql = lane & 31;
  u16* sK = (u16*)smem; u16* sV = sK + KT * KST; float* sB = (float*)(sV + DV * VST);
  const int G = H / KVH;
  const int t_lo = do_lat ? 0 : 128 * H, t_hi = do_ctx ? 132 * H : 128 * H;
  const float sl2 = scale * LOG2E;
  const int kgo = (tid >> 3) * DQK + (tid & 7) * 8, kso = (tid >> 3) * KST + (tid & 7) * 8;
  const int vgo = (tid / VCH) * TEXT + (tid % VCH) * 8, vso = (tid / VCH) * VST + (tid % VCH) * 8;
  for (int tile = t_lo + get_bid(); tile < t_hi; tile += gridDim.x) {
    const int h = tile % H, mt = tile / H;
    const bool isctx = mt >= 128;
    const int m0 = isctx ? ML + (mt - 128) * 128 : mt * 128;
    const int b = isctx ? (mt - 128) >> 1 : mt >> 6;
    const int kvh = h / G;
    const u16* Kg = Kf + (size_t)(b * KVH + kvh) * TEXT * DQK;
    const u16* Vg = VT + (size_t)(b * KVH + kvh) * DV * TEXT;
    const int qrow = m0 + wave * 32 + ql;
    bf16x8 qf[DQK / 16];
#pragma unroll
    for (int kk = 0; kk < DQK / 16; ++kk) qf[kk] = *(const bf16x8*)(Qf + (size_t)qrow * (H * DQK) + h * DQK + kk * 16 + hh * 8);
    int nkt = isctx ? 256 / KT : TEXT / KT, rbase = 0, qr = 0, r0q = 0;
    if (NA) {
      int s0 = m0 & 8191, r1 = s0 >> 6;
      rbase = clampi(r1 - 4, 0, 120);
      nkt = 4 + (clampi(r1 + 1 - 4, 0, 120) + 8 - rbase);
      qr = (s0 + wave * 32) >> 6; r0q = clampi(qr - 4, 0, 120);
    }
    __syncthreads();
    if (NA) { for (int i = tid; i < 465; i += 256) sB[i] = rpb[h * 465 + i] * LOG2E; }
    f32x16 o[NDVB];
#pragma unroll
    for (int i = 0; i < NDVB; ++i)
#pragma unroll
      for (int j = 0; j < 16; ++j) o[i][j] = 0.f;
    float mrun = -1e30f, lrun = 0.f;
    u32x4 kr[NKC], vr[NVC];
    {
      const int t0 = 0;
#pragma unroll
      for (int i = 0; i < NKC; ++i) kr[i] = *(const u32x4*)(Kg + (unsigned)(t0 * DQK + kgo + 32 * (i / KR) * DQK + 64 * (i % KR)));
#pragma unroll
      for (int i = 0; i < NVC; ++i) vr[i] = *(const u32x4*)(Vg + (unsigned)(t0 + vgo + i * (256 / VCH) * TEXT));
    }
    for (int it = 0; it < nkt; ++it) {
      __syncthreads();
#pragma unroll
      for (int i = 0; i < NKC; ++i) *(u32x4*)(sK + kso + 32 * (i / KR) * KST + 64 * (i % KR)) = kr[i];
#pragma unroll
      for (int i = 0; i < NVC; ++i) {
        *(u32x2*)(sV + vso + i * (256 / VCH) * VST) = (u32x2){vr[i][0], vr[i][1]};
        *(u32x2*)(sV + vso + i * (256 / VCH) * VST + 4) = (u32x2){vr[i][2], vr[i][3]};
      }
      __syncthreads();
      if (it + 1 < nkt) {
        const int itn = it + 1;
        const int t0 = (NA && itn >= 4) ? 256 + (rbase + itn - 4) * 64 : itn * KT;
#pragma unroll
        for (int i = 0; i < NKC; ++i) kr[i] = *(const u32x4*)(Kg + (unsigned)(t0 * DQK + kgo + 32 * (i / KR) * DQK + 64 * (i % KR)));
#pragma unroll
        for (int i = 0; i < NVC; ++i) vr[i] = *(const u32x4*)(Vg + (unsigned)(t0 + vgo + i * (256 / VCH) * TEXT));
      }
      const int krow = rbase + it - 4;
      const bool local = NA && it >= 4;
      if (local && !(krow >= r0q && krow < r0q + 8)) continue;
      f32x16 s[NKB];
#pragma unroll
      for (int kb = 0; kb < NKB; ++kb)
#pragma unroll
        for (int j = 0; j < 16; ++j) s[kb][j] = 0.f;
      {
        constexpr int NKK = DQK / 16, NQK = NKB * NKK, RD = (DQK > 128 && KT == 64) ? 2 : 4;
        bf16x8 kf[NQK];
#define LDK(i) (*(const bf16x8*)(sK + (((i) / NKK) * 32 + ql) * KST + ((i) % NKK) * 16 + hh * 8))
#pragma unroll
        for (int i = 0; i < RD; ++i) kf[i] = LDK(i);
        __builtin_amdgcn_sched_barrier(0);
#pragma unroll
        for (int i = 0; i < NQK; ++i) {
          if (i + RD < NQK) kf[i + RD] = LDK(i + RD);
          s[i / NKK] = MFMA32(kf[i], qf[i % NKK], s[i / NKK]);
          __builtin_amdgcn_sched_barrier(0);
        }
#undef LDK
      }
      float mloc = -1e30f;
      if (local) {
        const int qc = (wave & 1) * 32 + ql, csq = clampi(qc - 8, 0, 48);
        const int bro = (krow - qr + 7) * 31 - qc + 15;
#pragma unroll
        for (int kb = 0; kb < NKB; ++kb)
#pragma unroll
          for (int i = 0; i < 16; ++i) {
            int kc = kb * 32 + (i & 3) + 8 * (i >> 2) + 4 * hh;
            bool ok = kc >= csq && kc < csq + 16;
            float x = ok ? s[kb][i] * sl2 + sB[bro + kc] : -1e30f;
            s[kb][i] = x; mloc = fmaxf(mloc, x);
          }
      } else {
#pragma unroll
        for (int kb = 0; kb < NKB; ++kb)
#pragma unroll
          for (int i = 0; i < 16; ++i) mloc = fmaxf(mloc, s[kb][i]);
        mloc *= sl2;
      }
      mloc = fmaxf(mloc, __shfl_xor(mloc, 32));
      const float mnew = fmaxf(mrun, mloc);
      if (__any(mnew > mrun)) {
        const float alpha = ex2(mrun - mnew);
        mrun = mnew;
        lrun *= alpha;
#pragma unroll
        for (int i = 0; i < NDVB; ++i)
#pragma unroll
          for (int j = 0; j < 16; ++j) o[i][j] *= alpha;
      }
      float ls = 0.f;
      if (local) {
#pragma unroll
        for (int kb = 0; kb < NKB; ++kb)
#pragma unroll
          for (int i = 0; i < 16; ++i) { float e = ex2(s[kb][i] - mrun); s[kb][i] = e; ls += e; }
      } else {
        const float nm = -mrun;
#pragma unroll
        for (int kb = 0; kb < NKB; ++kb)
#pragma unroll
          for (int i = 0; i < 16; ++i) { float e = ex2(fmaf(s[kb][i], sl2, nm)); s[kb][i] = e; ls += e; }
      }
      lrun += ls;
      {
        constexpr int NPV = NKB * 2 * NDVB, RD = (DQK > 128 && KT == 64) ? 2 : 4;
        bf16x8 pf[NKB * 2], vf[NPV];
#pragma unroll
        for (int c = 0; c < NKB * 2; ++c) {
          const int kb = c >> 1, st = c & 1;
          u32x4 pw = {pack2(s[kb][8 * st], s[kb][8 * st + 1]), pack2(s[kb][8 * st + 2], s[kb][8 * st + 3]),
                      pack2(s[kb][8 * st + 4], s[kb][8 * st + 5]), pack2(s[kb][8 * st + 6], s[kb][8 * st + 7])};
          pf[c] = __builtin_bit_cast(bf16x8, pw);
        }
#define LDV(j) ({ const u16* vp_ = sV + (((j) % NDVB) * 32 + ql) * VST + ((j) / NDVB) * 16 + hh * 4; \
                  bf16x4 lo_ = *(const bf16x4*)vp_, hi_ = *(const bf16x4*)(vp_ + 8); __builtin_shufflevector(lo_, hi_, 0, 1, 2, 3, 4, 5, 6, 7); })
#pragma unroll
        for (int j = 0; j < RD; ++j) vf[j] = LDV(j);
        __builtin_amdgcn_sched_barrier(0);
#pragma unroll
        for (int j = 0; j < NPV; ++j) {
          if (j + RD < NPV) vf[j + RD] = LDV(j + RD);
          o[j % NDVB] = MFMA32(vf[j], pf[j / NDVB], o[j % NDVB]);
          __builtin_amdgcn_sched_barrier(0);
        }
#undef LDV
      }
    }
    lrun += __shfl_xor(lrun, 32);
    const float inv = 1.f / lrun;
#pragma unroll
    for (int dvb = 0; dvb < NDVB; ++dvb)
#pragma unroll
      for (int g = 0; g < 4; ++g) {
        int dv = dvb * 32 + 8 * g + 4 * hh;
        *(uint2*)(O + (size_t)qrow * (H * DV) + h * DV + dv) =
            make_uint2(pack2(o[dvb][4 * g] * inv, o[dvb][4 * g + 1] * inv), pack2(o[dvb][4 * g + 2] * inv, o[dvb][4 * g + 3] * inv));
      }
  }
}

DI void phase_ret_scan(PRM p, char* smem) {
  const int tid = get_tid(), lane = tid & 63, wave = tid >> 6, fr = lane & 15, fq = lane >> 4;
  u16* sST = (u16*)smem;
  float* sKD = (float*)(smem + 16896);
  const unsigned vlo = fr * TEXT + fq * 8;
  const unsigned klo = (wave * 64 + fr) * TEXT + fq * 8;
  const unsigned plo = (wave * 32 + fr) * 128 + fq * 8;
  const unsigned qlo = (wave * 32 + fr) * 1024 + fq * 8;
  const unsigned ylo = (wave * 32 + fr) * 2048 + fq * 4;
  for (int item = get_bid(); item < 256; item += gridDim.x) {
    const int bh = item & 7, slice = item >> 3, b = bh >> 2, h = bh & 3, v0 = slice * 16;
    const float ld2[2] = {p.in[28][h] * LOG2E, p.in[29][h] * LOG2E};
    const u16* VTb = (const u16*)(p.arena + A3_VT) + (size_t)(bh * 512 + v0) * TEXT;
    const u16* KTb = (const u16*)(p.arena + A3_KT) + (size_t)(bh * 256) * TEXT;
    f32x4 S[2][4];
#pragma unroll
    for (int d = 0; d < 2; ++d)
#pragma unroll
      for (int r = 0; r < 4; ++r) S[d][r] = (f32x4){0.f, 0.f, 0.f, 0.f};
    __syncthreads();
    sKD[tid] = tid < 128 ? ex2((float)(127 - tid) * ld2[0]) : ex2((float)(tid - 128) * ld2[1]);
    __syncthreads();
    for (int st = 0; st < 66; ++st) {
#pragma unroll
      for (int d = 0; d < 2; ++d) {
        float l2 = ld2[d];
        asm volatile("" : "+v"(l2));
        int text0, n = 0;
        if (st < 2) text0 = (d == 0 ? st : 1 - st) * 128;
        else { n = d == 0 ? st - 2 : 63 - (st - 2); text0 = 256 + n * 128; }
        bf16x8 vfr[4], kfr[4][4];
#pragma unroll
        for (int ks = 0; ks < 4; ++ks) vfr[ks] = *(const bf16x8*)(VTb + (vlo + text0 + ks * 32));
        if (st >= 2) {
          const int mrow = b * 8192 + n * 128;
          const bool first = (st - 2) < 32;
          const u16* Pb = (const u16*)(p.arena + A3_P) + (size_t)d * 512 * 128 * 128 + (size_t)(bh * 64 + n) * 16384;
          const u16* Qb = p.xn + (size_t)mrow * 1024 + h * 256;
          u16* Yb = (u16*)(p.arena + A3_Y) + (size_t)mrow * 2048 + h * 512 + v0;
#pragma unroll 1
          for (int ot = 0; ot < 2; ++ot) {
            f32x4 ain = (f32x4){0.f, 0.f, 0.f, 0.f}, acr = (f32x4){0.f, 0.f, 0.f, 0.f};
            bf16x8 pa[4], qa[8];
#pragma unroll
            for (int ks = 0; ks < 4; ++ks) pa[ks] = *(const bf16x8*)(Pb + (plo + ot * 16 * 128 + ks * 32));
#pragma unroll
            for (int ks = 0; ks < 8; ++ks) qa[ks] = *(const bf16x8*)(Qb + (qlo + ot * 16 * 1024 + ks * 32));
            u32x2 yw = *(const u32x2*)(Yb + (ylo + ot * 16 * 2048));
            if (first) yw = (u32x2){0u, 0u};
            f32x4 yold;
            yold[0] = __uint_as_float(yw[0] << 16); yold[1] = __uint_as_float(yw[0] & 0xffff0000u);
            yold[2] = __uint_as_float(yw[1] << 16); yold[3] = __uint_as_float(yw[1] & 0xffff0000u);
#pragma unroll
            for (int ks = 0; ks < 4; ++ks) ain = MFMA16(vfr[ks], pa[ks], ain);
#pragma unroll
            for (int ks = 0; ks < 8; ++ks) {
              bf16x8 bb = *(const bf16x8*)(sST + (d * 16 + fr) * 264 + ks * 32 + fq * 8);
              acr = MFMA16(bb, qa[ks], acr);
            }
            {
              const int q = wave * 32 + ot * 16 + fr;
              const float qd = d == 0 ? ex2((float)(q + 1) * l2) : ex2((float)(128 - q) * l2);
              *(u32x2*)(Yb + (ylo + ot * 16 * 2048)) = (u32x2){pack2(ain[0] + acr[0] * qd + yold[0], ain[1] + acr[1] * qd + yold[1]),
                                                              pack2(ain[2] + acr[2] * qd + yold[2], ain[3] + acr[3] * qd + yold[3])};
            }
          }
        }
#pragma unroll
        for (int rt = 0; rt < 4; ++rt)
#pragma unroll
          for (int ks = 0; ks < 4; ++ks) kfr[rt][ks] = *(const bf16x8*)(KTb + (klo + rt * 16 * TEXT + text0 + ks * 32));
        const float cd = ex2(128.f * l2);
#pragma unroll
        for (int ks = 0; ks < 4; ++ks) {
          unsigned w[4];
          const f32x4 k0 = *(const f32x4*)(sKD + d * 128 + ks * 32 + fq * 8), k1 = *(const f32x4*)(sKD + d * 128 + ks * 32 + fq * 8 + 4);
          w[0] = pack2(bf2f((u16)vfr[ks][0]) * k0[0], bf2f((u16)vfr[ks][1]) * k0[1]);
          w[1] = pack2(bf2f((u16)vfr[ks][2]) * k0[2], bf2f((u16)vfr[ks][3]) * k0[3]);
          w[2] = pack2(bf2f((u16)vfr[ks][4]) * k1[0], bf2f((u16)vfr[ks][5]) * k1[1]);
          w[3] = pack2(bf2f((u16)vfr[ks][6]) * k1[2], bf2f((u16)vfr[ks][7]) * k1[3]);
          vfr[ks] = __builtin_bit_cast(bf16x8, (u32x4){w[0], w[1], w[2], w[3]});
        }
#pragma unroll
        for (int rt = 0; rt < 4; ++rt) {
          S[d][rt] *= cd;
#pragma unroll
          for (int ks = 0; ks < 4; ++ks) S[d][rt] = MFMA16(kfr[rt][ks], vfr[ks], S[d][rt]);
        }
        __builtin_amdgcn_sched_barrier(0);
      }
      __syncthreads();
#pragma unroll
      for (int d = 0; d < 2; ++d)
#pragma unroll
        for (int rt = 0; rt < 4; ++rt)
          *(uint2*)(sST + (d * 16 + fr) * 264 + wave * 64 + rt * 16 + fq * 4) = make_uint2(pack2(S[d][rt][0], S[d][rt][1]), pack2(S[d][rt][2], S[d][rt][3]));
      __syncthreads();
    }
  }
}

#define XB_TMO      128
#define XB_XCNT(j)  (256  + 64 * (j))
#define XB_XSUB(j)  (1280 + 64 * (j))
#define XB_XGEN(j)  (2304 + 64 * (j))
#define XB_TOP      3328
#define XB_TOPGEN   3392
#define XCD_BAR_WORDS 3456
#define XB_SPIN_CAP (1u << 18)
#define LAS __attribute__((address_space(3)))

__device__ __forceinline__ unsigned xb_ld(unsigned* p)              { return __hip_atomic_load(p, __ATOMIC_RELAXED, __HIP_MEMORY_SCOPE_AGENT); }
__device__ __forceinline__ unsigned xb_add(unsigned* p, unsigned v) { return __hip_atomic_fetch_add(p, v, __ATOMIC_RELAXED, __HIP_MEMORY_SCOPE_AGENT); }
__device__ __forceinline__ unsigned xb_xcc_id() { return (unsigned)__builtin_amdgcn_s_getreg((3 << 11) | 20) & 0xFu; }
#define XB_SPIN(cond, bar) do { unsigned _sp = 0; while (cond) { __builtin_amdgcn_s_sleep(1); \
    if ((++_sp & 255u) == 0u) { if (xb_ld(&(bar)[XB_TMO])) break; if (_sp > XB_SPIN_CAP) { atomicAdd(&(bar)[XB_TMO], 1u); break; } } } } while (0)

struct XcdBarrier {
    unsigned* bar; unsigned x;
    volatile LAS unsigned* st;
};

__device__ __forceinline__ XcdBarrier xcd_barrier_post(unsigned* bar, volatile LAS unsigned* st) {
    XcdBarrier b; b.bar = bar; b.x = xb_xcc_id(); b.st = st;
    if (threadIdx.x == 0) (void)xb_add(&bar[XB_XCNT(b.x)], 1u);
    return b;
}
__device__ __forceinline__ void xcd_barrier_complete(unsigned* bar, unsigned x, unsigned& nloc, unsigned& nx) {
    const unsigned G = gridDim.x * gridDim.y * gridDim.z;
    unsigned sum, cnt, mine, sp = 0u;
    for (;;) {
        sum = 0u; cnt = 0u; mine = 0u;
#pragma unroll
        for (unsigned j = 0; j < 16; ++j) { const unsigned c = xb_ld(&bar[XB_XCNT(j)]); sum += c; cnt += (c > 0u) ? 1u : 0u; mine = (j == x) ? c : mine; }
        if (sum == G) break;
        __builtin_amdgcn_s_sleep(1);
        if ((++sp & 255u) == 0u) { if (xb_ld(&bar[XB_TMO])) break; if (sp > XB_SPIN_CAP) { atomicAdd(&bar[XB_TMO], 1u); break; } }
    }
    nloc = mine > 0u ? mine : 1u; nx = cnt > 0u ? cnt : 1u;
}

__device__ __forceinline__ void xcd_barrier(const XcdBarrier& b) {
    asm volatile("s_waitcnt vmcnt(0)" ::: "memory");
    __syncthreads();
    if (threadIdx.x == 0) {
        unsigned* bar = b.bar;
        __builtin_amdgcn_s_waitcnt(0);
        unsigned nloc = b.st[0], nx = b.st[1];
        if (nloc == 0u) { xcd_barrier_complete(bar, b.x, nloc, nx); b.st[0] = nloc; b.st[1] = nx; }
        const unsigned old = xb_add(&bar[XB_XSUB(b.x)], 1u);
        const unsigned gen = old / nloc;
        if (old + 1u == (gen + 1u) * nloc) {
            __builtin_amdgcn_fence(__ATOMIC_RELEASE, "agent");
            asm volatile("s_waitcnt vmcnt(0)" ::: "memory");
            const unsigned og = xb_add(&bar[XB_TOP], 1u);
            const unsigned tg = og / nx;
            if (og + 1u == (tg + 1u) * nx) xb_add(&bar[XB_TOPGEN], 1u);
            else XB_SPIN(xb_ld(&bar[XB_TOPGEN]) == tg, bar);
            __builtin_amdgcn_fence(__ATOMIC_ACQUIRE, "agent");
            xb_add(&bar[XB_XGEN(b.x)], 1u);
            asm volatile("s_waitcnt vmcnt(0)" ::: "memory");
        } else {
            XB_SPIN(xb_ld(&bar[XB_XGEN(b.x)]) == gen, bar);
            __builtin_amdgcn_fence(__ATOMIC_ACQUIRE, "agent");
            asm volatile("s_waitcnt vmcnt(0)" ::: "memory");
        }
    }
    __syncthreads();
}


__global__ void __launch_bounds__(256, 2) fwd_megakernel(Params p_unused) {
  typedef const __attribute__((address_space(4))) Params CParams;
  __shared__ __attribute__((aligned(16))) char smem[61440];
  cg::grid_group grid = cg::this_grid();
  int rep = 0;
  CParams* pp0 = (CParams*)__builtin_amdgcn_kernarg_segment_ptr();
  __shared__ uint4 xb_words;
  if (threadIdx.x == 0) xb_words = make_uint4(0u, 0u, 0u, 0u);
  __syncthreads();
  XcdBarrier xb = xcd_barrier_post(pp0->bar, (volatile LAS unsigned*)&xb_words);
  const int ph_lo = pp0->phase_lo, ph_hi = pp0->phase_hi;
  for (int ph = ph_lo; ph < ph_hi; ++ph) {
    CParams* pp = pp0;
    asm volatile("" : "+s"(pp));
    PRM p = *pp;
    switch (ph) {
      case 0: phase_init(p, smem); break;
      case 1: phase_norm(p, 0, 0, MALL); break;
      case 11: convert_layer(p, 1, smem); phase_norm(p, 1, 0, MALL); break;
      case 19: convert_layer(p, 2, smem); phase_norm(p, 2, 0, MALL); break;
      case 27: convert_layer(p, 3, smem); phase_norm(p, 3, 0, MALL); break;
      case 8: phase_norm(p, 0, 1, MALL); break;
      case 16: phase_norm(p, 1, 1, MALL); break;
      case 24: phase_norm(p, 2, 1, MALL); break;
      case 34: phase_norm(p, 3, 1, MALL); break;
      case 3: phase_mla_post1(p); break;
      case 5: phase_mla_post2(p); break;
      case 13: phase_gqa_post(p); break;
      case 21: phase_na_post(p); break;
      case 29: phase_ret_post(p, smem); break;
      case 6:
        attn_phase<192, 128, false, 64>(p, (const u16*)(p.arena + A0_Q), (const u16*)(p.arena + A0_K), (const u16*)(p.arena + A0_VT), (u16*)(p.arena + A0_O), 8, 8,
                                    0.07216878364870322f, nullptr, true, true, smem);
        break;
      case 14:
        attn_phase<128, 128, false, 64>(p, (const u16*)(p.arena + A1_Q), (const u16*)(p.arena + A1_K), (const u16*)(p.arena + A1_VT), (u16*)(p.arena + A1_O), 8, 2,
                                    0.08838834764831845f, nullptr, true, true, smem);
        break;
      case 22:
        attn_phase<64, 64, true, 64>(p, (const u16*)(p.arena + A2_Q), (const u16*)(p.arena + A2_K), (const u16*)(p.arena + A2_VT), (u16*)(p.arena + A2_O), 16, 16,
                                 0.125f, p.in[25], true, false, smem);
        attn_phase<64, 64, false, 64>(p, (const u16*)(p.arena + A2_Q), (const u16*)(p.arena + A2_K), (const u16*)(p.arena + A2_VT), (u16*)(p.arena + A2_O), 16, 16,
                                  0.125f, nullptr, false, true, smem);
        break;
      case 31: phase_ret_scan(p, smem); break;
      case 32: phase_ret_gate(p); break;
      default:
#ifdef DBG_SKIP
        if (ph == DBG_SKIP) break;
#endif
        gemm_phase(p, ph, smem); break;
    }
#ifdef REPEAT_PH
    if (ph == REPEAT_PH && !rep) { rep = 1; xcd_barrier(xb); --ph; continue; }
    rep = 0;
#endif
    if (ph + 1 < ph_hi) { if (ph_lo < 0) grid.sync(); else xcd_barrier(xb); }
  }
}

extern "C" void kernel_launch(void* const* d_in, const int* in_sizes, int n_in, void* d_out, int out_size, void* d_ws, size_t ws_size,
                              hipStream_t stream) {
  static int grid_blocks = 0;
  if (!grid_blocks) {
    int dev = 0, cus = 0, per_cu = 0;
    hipGetDevice(&dev);
    hipDeviceGetAttribute(&cus, hipDeviceAttributeMultiprocessorCount, dev);
    hipOccupancyMaxActiveBlocksPerMultiprocessor(&per_cu, fwd_megakernel, 256, 0);
    if (per_cu > 2) per_cu = 2;
    grid_blocks = cus * per_cu;
  }
  Params p{};
  for (int i = 0; i < 32; ++i) p.in[i] = (const float*)d_in[i];
  p.out = (float*)d_out;
  char* ws = (char*)d_ws;
  size_t off = 0;
  p.modv = (float*)(ws + off); off += 4 * 3 * 6144 * 4;
  p.tab = (float2*)(ws + off); off += 128 * 112 * 8;
  p.hctx = (float*)(ws + off); off += (size_t)512 * 1024 * 4;
  p.wt = (u16*)(ws + off); off += WT_ELEMS * 2;
  p.xn = (u16*)(ws + off); off += (size_t)MALL * 1024 * 2;
  p.arena = ws + off; off += ARENA_BYTES;
  p.bar = (unsigned*)(ws + off); off += XCD_BAR_WORDS * 4;
  if (off > ws_size) { fprintf(stderr, "workspace too small: need %zu have %zu\n", off, ws_size); return; }
  p.phase_lo = 0; p.phase_hi = NPHASE;
  (void)hipMemsetAsync(p.bar, 0, XCD_BAR_WORDS * 4, stream);
  void* args[] = {&p};
  hipError_t e = hipLaunchCooperativeKernel((void*)fwd_megakernel, dim3(grid_blocks), dim3(256), args, 0, stream);
  if (e != hipSuccess) fprintf(stderr, "cooperative launch failed: %s (grid %d)\n", hipGetErrorString(e), grid_blocks);
}
```

```cpp
#define BIGBK 64
#define BIGDIST 2
#include <hip/hip_runtime.h>
#include <hip/hip_cooperative_groups.h>
#include <cstdio>
namespace cg = cooperative_groups;

#define DI __device__ __forceinline__
typedef unsigned short u16;
typedef __attribute__((ext_vector_type(8))) short bf16x8;
typedef __attribute__((ext_vector_type(4))) short bf16x4;
typedef __attribute__((ext_vector_type(4))) float f32x4;
typedef __attribute__((ext_vector_type(16))) float f32x16;
typedef __attribute__((ext_vector_type(2))) float f32x2;
typedef __attribute__((ext_vector_type(4))) unsigned u32x4;
typedef __attribute__((ext_vector_type(2))) unsigned u32x2;
typedef __attribute__((ext_vector_type(2))) __bf16 bfv2;

constexpr int D = 1024, ML = 16384, MALL = 16896, TEXT = 8448, FH = 2816;
constexpr float LOG2E = 1.4426950408889634f;
constexpr float EPS = 1e-6f;
constexpr size_t W13T = 0, W2T = 5767168, MIX = 8650752;
constexpr size_t WT_ELEMS = MIX + 8388608;
constexpr int NPHASE = 37;
#ifndef BANDH
#define BANDH 4
#endif
#ifndef BIGBK
#define BIGBK 32
#define BIGDIST 3
#endif

struct Params {
  const float* in[32];
  float* out;
  float* modv;
  float2* tab;
  float* hctx;
  u16* wt;
  u16* xn;
  char* arena;
  unsigned* bar;
  int phase_lo, phase_hi;
};

#define PRM const __attribute__((address_space(4))) Params&
DI int get_tid() { int t = threadIdx.x; asm volatile("" : "+v"(t)); return t; }
DI int get_bid() { int b = blockIdx.x; asm volatile("" : "+s"(b)); return b; }
DI u16 f2bf(float x) { __bf16 b = (__bf16)x; return __builtin_bit_cast(u16, b); }
DI float bf2f(u16 v) { return __uint_as_float(((unsigned)v) << 16); }
DI unsigned pack2(float a, float b) { f32x2 f = {a, b}; bfv2 r = __builtin_convertvector(f, bfv2); return __builtin_bit_cast(unsigned, r); }
DI float wave_sum(float v) { for (int o = 32; o > 0; o >>= 1) v += __shfl_xor(v, o); return v; }
DI float silu(float x) { return x / (1.f + __expf(-x)); }
DI float ex2(float x) { return __builtin_amdgcn_exp2f(x); }
DI int clampi(int x, int lo, int hi) { return x < lo ? lo : (x > hi ? hi : x); }
DI int mod_idx(int m) { return m < 8192 ? 0 : (m < ML ? 1 : 2); }
DI void tok_bt(int m, int& b, int& t) { if (m < ML) { b = m >> 13; t = 256 + (m & 8191); } else { int c = m - ML; b = c >> 8; t = c & 255; } }
DI float* hrow(PRM p, int m) { return m < ML ? p.out + (size_t)m * D : p.hctx + (size_t)(m - ML) * D; }
#define MFMA16(a, b, c) __builtin_amdgcn_mfma_f32_16x16x32_bf16((a), (b), (c), 0, 0, 0)
#define MFMA32(a, b, c) __builtin_amdgcn_mfma_f32_32x32x16_bf16((a), (b), (c), 0, 0, 0)

DI int map_row(int mode, int n) {
  if (mode == 1) return n < FH ? 2 * n : 2 * (n - FH) + 1;
  if (mode == 2) { int h = n >> 8, c = n & 255; return c < 128 ? h * 128 + c : 1024 + h * 128 + (c - 128); }
  return n;
}
DI void convert_job(const float* src, int K, int N, int Npad, u16* dst, int mode, char* smem) {
  float* sT = (float*)smem;
  const int tid = get_tid();
  const int nkt = K >> 6, ntot = nkt * (Npad >> 6);
  for (int tile = get_bid(); tile < ntot; tile += gridDim.x) {
    const int k0 = (tile % nkt) * 64, n0 = (tile / nkt) * 64;
    __syncthreads();
#pragma unroll
    for (int i = 0; i < 4; ++i) {
      int r = (tid >> 4) + 16 * i, c4 = (tid & 15) * 4;
      float4 v = make_float4(0.f, 0.f, 0.f, 0.f);
      if (n0 + c4 < N) v = *(const float4*)(src + (size_t)(k0 + r) * N + n0 + c4);
      sT[r * 65 + c4] = v.x; sT[r * 65 + c4 + 1] = v.y; sT[r * 65 + c4 + 2] = v.z; sT[r * 65 + c4 + 3] = v.w;
    }
    __syncthreads();
#pragma unroll
    for (int i = 0; i < 2; ++i) {
      int c = tid + 256 * i, n = c >> 3, kc = c & 7;
      float f[8];
#pragma unroll
      for (int j = 0; j < 8; ++j) f[j] = sT[(kc * 8 + j) * 65 + n];
      uint4 pk = make_uint4(pack2(f[0], f[1]), pack2(f[2], f[3]), pack2(f[4], f[5]), pack2(f[6], f[7]));
      int nn = n0 + n;
      int row = nn < N ? map_row(mode, nn) : nn;
      *(uint4*)(dst + (size_t)row * K + k0 + kc * 8) = pk;
    }
  }
  __syncthreads();
}
DI void convert_layer(PRM p, int l, char* smem) {
  convert_job(p.in[8] + (size_t)l * 1024 * 5632, 1024, 5632, 5632, p.wt + W13T, 1, smem);
  convert_job(p.in[9] + (size_t)l * 2816 * 1024, 2816, 1024, 1024, p.wt + W2T, 0, smem);
  if (l == 0) {
    convert_job(p.in[10], 1024, 704, 768, p.wt + MIX, 0, smem);
    convert_job(p.in[13], 384, 1536, 1536, p.wt + MIX + 786432, 0, smem);
    convert_job(p.in[14], 256, 2048, 2048, p.wt + MIX + 786432 + 589824, 2, smem);
    convert_job(p.in[17], 1024, 1024, 1024, p.wt + MIX + 786432 + 589824 + 524288, 0, smem);
  } else if (l == 1) {
    convert_job(p.in[18], 1024, 1536, 1536, p.wt + MIX, 0, smem);
    convert_job(p.in[21], 1024, 1024, 1024, p.wt + MIX + 1572864, 0, smem);
  } else if (l == 2) {
    convert_job(p.in[22], 1024, 3072, 3072, p.wt + MIX, 0, smem);
    convert_job(p.in[26], 1024, 1024, 1024, p.wt + MIX + 3145728, 0, smem);
  } else {
    convert_job(p.in[27], 1024, 6144, 6144, p.wt + MIX, 0, smem);
    convert_job(p.in[31], 2048, 1024, 1024, p.wt + MIX + 6291456, 0, smem);
  }
}

DI void phase_init(PRM p, char* smem) {
  const int tid = get_tid(), lane = tid & 63, wave = tid >> 6;
  const size_t gtid = (size_t)get_bid() * 256 + tid, gstr = (size_t)gridDim.x * 256;
  {
    const float4* s2 = (const float4*)p.in[2]; float4* d2 = (float4*)p.hctx;
    for (size_t i = gtid; i < (size_t)512 * D / 4; i += gstr) d2[i] = s2[i];
  }
  for (size_t idx = gtid; idx < 128 * 112; idx += gstr) {
    int Qt, loc;
    if (idx < 2048) { Qt = 16; loc = (int)idx; } else if (idx < 6144) { Qt = 32; loc = (int)idx - 2048; } else { Qt = 64; loc = (int)idx - 6144; }
    int pos = loc / Qt, j = loc % Qt;
    float inv = exp2f(-(float)j / (float)Qt * 13.287712379549449f);
    float ang = (float)pos * inv;
    p.tab[idx] = make_float2(cosf(ang), sinf(ang));
  }
  {
    float* sc = (float*)smem;
    float* red = sc + 3 * 1024;
    if (get_bid() < 384) {
      for (int i = tid; i < 3072; i += 256) {
        int v = i >> 10, k = i & 1023;
        float x = v < 2 ? p.in[1][v * 1024 + k] : p.in[3][k];
        sc[i] = silu(x);
      }
    }
    __syncthreads();
    for (int cb = get_bid(); cb < 384; cb += gridDim.x) {
      int l = cb / 96, n = (cb % 96) * 64 + lane;
      const float* w = p.in[4] + (size_t)l * 1024 * 6144 + n;
      float a0 = 0.f, a1 = 0.f, a2 = 0.f;
      int kb = wave * 256;
#pragma unroll 8
      for (int k = 0; k < 256; ++k) {
        float wv = w[(size_t)(kb + k) * 6144];
        a0 += sc[kb + k] * wv; a1 += sc[1024 + kb + k] * wv; a2 += sc[2048 + kb + k] * wv;
      }
      red[(wave * 3 + 0) * 64 + lane] = a0; red[(wave * 3 + 1) * 64 + lane] = a1; red[(wave * 3 + 2) * 64 + lane] = a2;
      __syncthreads();
      if (tid < 192) {
        int v = tid >> 6;
        float s = red[(0 * 3 + v) * 64 + lane] + red[(1 * 3 + v) * 64 + lane] + red[(2 * 3 + v) * 64 + lane] + red[(3 * 3 + v) * 64 + lane];
        p.modv[(size_t)(l * 3 + v) * 6144 + n] = s + p.in[5][l * 6144 + n];
      }
      __syncthreads();
    }
  }
  convert_layer(p, 0, smem);
}

DI void phase_norm(PRM p, int l, int which, int Mrows) {
  const int lane = get_tid() & 63, wave = get_tid() >> 6;
  const float* gain = p.in[which ? 7 : 6] + l * D;
  const int sc_off = which ? 4 * D : D, sh_off = which ? 3 * D : 0;
  const int stride = gridDim.x * 4;
  for (int m0 = get_bid() * 4 + wave; m0 < Mrows; m0 += 4 * stride) {
    float4 v[4][4]; float ss[4];
#pragma unroll
    for (int k = 0; k < 4; ++k) {
      const int m = m0 + k * stride;
      ss[k] = 0.f;
      if (m < Mrows) {
        const float* h = (l == 0 && which == 0 && m < ML) ? p.in[0] + (size_t)m * D : hrow(p, m);
#pragma unroll
        for (int i = 0; i < 4; ++i) v[k][i] = *(const float4*)(h + i * 256 + lane * 4);
      } else {
#pragma unroll
        for (int i = 0; i < 4; ++i) v[k][i] = make_float4(0.f, 0.f, 0.f, 0.f);
      }
    }
#pragma unroll
    for (int k = 0; k < 4; ++k) {
#pragma unroll
      for (int i = 0; i < 4; ++i) ss[k] += v[k][i].x * v[k][i].x + v[k][i].y * v[k][i].y + v[k][i].z * v[k][i].z + v[k][i].w * v[k][i].w;
      ss[k] = wave_sum(ss[k]);
    }
#pragma unroll
    for (int k = 0; k < 4; ++k) {
      const int m = m0 + k * stride;
      if (m < Mrows) {
        const float* mv = p.modv + (size_t)(l * 3 + mod_idx(m)) * 6144;
        const float r = rsqrtf(ss[k] * (1.f / 1024.f) + EPS);
#pragma unroll
        for (int i = 0; i < 4; ++i) {
          int c = i * 256 + lane * 4;
          float4 g = *(const float4*)(gain + c), sc = *(const float4*)(mv + sc_off + c), sh = *(const float4*)(mv + sh_off + c);
          float y0 = v[k][i].x * r * g.x * (1.f + sc.x) + sh.x, y1 = v[k][i].y * r * g.y * (1.f + sc.y) + sh.y;
          float y2 = v[k][i].z * r * g.z * (1.f + sc.z) + sh.z, y3 = v[k][i].w * r * g.w * (1.f + sc.w) + sh.w;
          *(uint2*)(p.xn + (size_t)m * D + c) = make_uint2(pack2(y0, y1), pack2(y2, y3));
        }
      }
    }
  }
}

enum { EPI_STORE = 0, EPI_VT = 1, EPI_RESID = 2, EPI_SWIGLU = 3, EPI_RETP = 4 };
struct GJob { const u16* P; const u16* Q; int ldp, ldq, K, nI, nJ, epi; u16* o; int ld, a, b; };

DI GJob mkjob(const u16* P, int ldp, const u16* Q, int ldq, int K, int nI, int nJ, int epi, u16* o, int ld, int a, int b) {
  GJob J; J.P = P; J.Q = Q; J.ldp = ldp; J.ldq = ldq; J.K = K; J.nI = nI; J.nJ = nJ; J.epi = epi; J.o = o; J.ld = ld; J.a = a; J.b = b; return J;
}
constexpr size_t A0_RAW1 = 0, A0_CQN = 25952256, A0_CKVN = A0_CQN + 12976128, A0_QRAW = A0_CKVN + 8650752, A0_KNRAW = A0_QRAW + 51904512,
                 A0_Q = A0_KNRAW + 34603008, A0_K = A0_Q + 51904512, A0_VT = A0_K + 51904512, A0_O = A0_QRAW;
constexpr size_t A1_RAW = 0, A1_Q = 43253760, A1_K = A1_Q + 34603008, A1_VT = A1_K + 8650752, A1_O = A1_VT + 8650752;
constexpr size_t A2_RAW = 0, A2_Q = 69206016, A2_K = A2_Q + 34603008, A2_VT = A2_K + 34603008, A2_O = A2_VT + 34603008;
constexpr size_t A3_RAW = 0, A3_Y = 0, A3_VT = 69206016, A3_U = A3_VT, A3_G = A3_VT + 69206016, A3_KN = A3_G + 67108864, A3_KT = A3_KN + 33554432,
                 A3_P = A3_KT + 34603008, A3_END = A3_P + 33554432;
constexpr size_t ARENA_BYTES = A3_END;

DI GJob make_job(PRM p, int ph, int jj) {
  u16* ar = (u16*)p.arena;
  const u16* wt = p.wt;
  GJob Z = mkjob(nullptr, 0, nullptr, 0, 0, 0, 0, 0, nullptr, 0, 0, 0);
  switch (ph) {
    case 2: if (jj == 0) return mkjob(wt + MIX, 1024, p.xn, 1024, 1024, 3, 132, EPI_STORE, (u16*)(p.arena + A0_RAW1), 768, 768, 0); break;
    case 4:
      if (jj == 0) return mkjob(wt + MIX + 786432, 384, (u16*)(p.arena + A0_CQN), 384, 384, 6, 132, EPI_STORE, (u16*)(p.arena + A0_QRAW), 1536, 1536, 0);
      if (jj == 1) return mkjob(wt + MIX + 786432 + 589824, 256, (u16*)(p.arena + A0_CKVN), 256, 256, 4, 132, EPI_STORE, (u16*)(p.arena + A0_KNRAW), 1024, 1024, 0);
      if (jj == 2) return mkjob((u16*)(p.arena + A0_CKVN), 256, wt + MIX + 786432 + 589824 + 1024 * 256, 256, 256, 66, 8, EPI_VT, (u16*)(p.arena + A0_VT), 0, 7, 8);
      break;
    case 7: if (jj == 0) return mkjob(wt + MIX + 786432 + 589824 + 524288, 1024, (u16*)(p.arena + A0_O), 1024, 1024, 8, 176, EPI_RESID, nullptr, 0, 0, 2 * D); break;
    case 12:
      if (jj == 0) return mkjob(wt + MIX, 1024, p.xn, 1024, 1024, 5, 132, EPI_STORE, (u16*)(p.arena + A1_RAW), 1280, 1280, 0);
      if (jj == 1) return mkjob(p.xn, 1024, wt + MIX + 1280 * 1024, 1024, 1024, 66, 2, EPI_VT, (u16*)(p.arena + A1_VT), 0, 7, 2);
      break;
    case 15: if (jj == 0) return mkjob(wt + MIX + 1572864, 1024, (u16*)(p.arena + A1_O), 1024, 1024, 8, 176, EPI_RESID, nullptr, 0, 1, 2 * D); break;
    case 20:
      if (jj == 0) return mkjob(wt + MIX, 1024, p.xn, 1024, 1024, 8, 132, EPI_STORE, (u16*)(p.arena + A2_RAW), 2048, 2048, 0);
      if (jj == 1) return mkjob(p.xn, 1024, wt + MIX + 2048 * 1024, 1024, 1024, 66, 8, EPI_VT, (u16*)(p.arena + A2_VT), 0, 6, 16);
      break;
    case 23: if (jj == 0) return mkjob(wt + MIX + 3145728, 1024, (u16*)(p.arena + A2_O), 1024, 1024, 8, 176, EPI_RESID, nullptr, 0, 2, 2 * D); break;
    case 28:
      if (jj == 0) return mkjob(wt + MIX, 1024, p.xn, 1024, 1024, 8, 132, EPI_STORE, (u16*)(p.arena + A3_RAW), 2048, 2048, 0);
      if (jj == 1) return mkjob(p.xn, 1024, wt + MIX + 2048 * 1024, 1024, 1024, 66, 16, EPI_VT, (u16*)(p.arena + A3_VT), 0, 9, 4);
      if (jj == 2) return mkjob(wt + MIX + 4096 * 1024, 1024, p.xn, 1024, 1024, 8, 128, EPI_STORE, (u16*)(p.arena + A3_G), 2048, 2048, 0);
      break;
    case 30: if (jj == 0) return mkjob((u16*)(p.arena + A3_KN), 1024, p.xn, 1024, 256, 512, 1, EPI_RETP, (u16*)(p.arena + A3_P), 0, 0, 0); break;
    case 33: if (jj == 0) return mkjob(wt + MIX + 6291456, 2048, (u16*)(p.arena + A3_U), 2048, 2048, 8, 176, EPI_RESID, nullptr, 0, 3, 2 * D); break;
    case 9: case 17: case 25: case 35:
      if (jj == 0) return mkjob(wt + W13T, 1024, p.xn, 1024, 1024, 22, 132, EPI_SWIGLU, ar, 0, 0, 0);
      break;
    case 10: case 18: case 26: case 36:
      if (jj == 0) return mkjob(wt + W2T, 2816, ar, 2816, 2816, 8, 176, EPI_RESID, nullptr, 0, (ph - 10) / 8 + (ph == 36 ? 0 : 0), 5 * D);
      break;
    default: break;
  }
  return Z;
}

template <int MT, int NT, int BK, int DIST>
DI void gemm_core(PRM p, const GJob& J, const u16* Pb, const u16* Qb, int i0, int j0, int aux, char* smem) {
  constexpr int LS = BK + 16, CPR = BK / 8;
  constexpr int RPI = 256 / CPR, NP = MT * 32 / RPI, NQ = NT * 32 / RPI, KS = BK / 32;
  const int tid = get_tid(), lane = tid & 63, wave = tid >> 6, wi = wave >> 1, wj = wave & 1, fr = lane & 15, fq = lane >> 4;
  u16* sP = (u16*)smem; u16* sQ = sP + MT * 32 * LS;
  f32x4 acc[MT][NT];
#pragma unroll
  for (int a = 0; a < MT; ++a)
#pragma unroll
    for (int b = 0; b < NT; ++b) acc[a][b] = (f32x4){0.f, 0.f, 0.f, 0.f};
  const u16* gpb = Pb + (size_t)i0 * J.ldp;
  const u16* gqb = Qb + (size_t)j0 * J.ldq;
  const unsigned po = (tid / CPR) * J.ldp + (tid % CPR) * 8, qo = (tid / CPR) * J.ldq + (tid % CPR) * 8;
  const unsigned spr = RPI * J.ldp, sqr = RPI * J.ldq;
  u32x4 rp[NP], rq[NQ];
#pragma unroll
  for (int i = 0; i < NP; ++i) rp[i] = *(const u32x4*)(gpb + (po + spr * i));
#pragma unroll
  for (int i = 0; i < NQ; ++i) rq[i] = *(const u32x4*)(gqb + (qo + sqr * i));
  const int nk = J.K / BK;
  const int so = (tid / CPR) * LS + (tid % CPR) * 8;
  for (int kt = 0; kt < nk; ++kt) {
    __syncthreads();
#pragma unroll
    for (int i = 0; i < NP; ++i) *(u32x4*)(sP + so + RPI * LS * i) = rp[i];
#pragma unroll
    for (int i = 0; i < NQ; ++i) *(u32x4*)(sQ + so + RPI * LS * i) = rq[i];
    __syncthreads();
    if (kt + 1 < nk) {
#pragma unroll
      for (int i = 0; i < NP; ++i) rp[i] = *(const u32x4*)(gpb + (po + spr * i + (kt + 1) * BK));
#pragma unroll
      for (int i = 0; i < NQ; ++i) rq[i] = *(const u32x4*)(gqb + (qo + sqr * i + (kt + 1) * BK));
    }
#pragma unroll
    for (int ks = 0; ks < KS; ++ks) {
      bf16x8 b[NT], a[MT];
#pragma unroll
      for (int nj = 0; nj < NT; ++nj) b[nj] = *(const bf16x8*)(sQ + (wj * NT * 16 + nj * 16 + fr) * LS + ks * 32 + fq * 8);
#define LDA(m) (*(const bf16x8*)(sP + (wi * MT * 16 + (m) * 16 + fr) * LS + ks * 32 + fq * 8))
#pragma unroll
      for (int m = 0; m < DIST; ++m) a[m] = LDA(m);
      __builtin_amdgcn_sched_barrier(0);
#pragma unroll
      for (int mi = 0; mi < MT; ++mi) {
        if (mi + DIST < MT) a[mi + DIST] = LDA(mi + DIST);
#pragma unroll
        for (int nj = 0; nj < NT; ++nj) acc[mi][nj] = MFMA16(a[mi], b[nj], acc[mi][nj]);
        __builtin_amdgcn_sched_barrier(0);
      }
#undef LDA
    }
  }
  if (MT == 8 && J.epi == EPI_SWIGLU) {
    u16* sO = (u16*)smem;
    __syncthreads();
#pragma unroll
    for (int mi = 0; mi < MT; ++mi)
#pragma unroll
      for (int nj = 0; nj < NT; ++nj) {
        const int ul = (wi * MT * 16 + mi * 16 + fq * 4) >> 1, jl = wj * NT * 16 + nj * 16 + fr;
        const f32x4 v = acc[mi][nj];
        *(unsigned*)(sO + jl * 136 + ul) = pack2(silu(v[0]) * v[1], silu(v[2]) * v[3]);
      }
    __syncthreads();
    const int row = tid >> 1, half = tid & 1;
    u16* dst = J.o + (size_t)(j0 + row) * FH + (i0 >> 1) + half * 64;
#pragma unroll
    for (int c = 0; c < 8; ++c) *(u32x4*)(dst + c * 8) = *(const u32x4*)(sO + row * 136 + half * 64 + c * 8);
    return;
  }
  if (NT == 3 && J.epi == EPI_RESID) {
    float* sO = (float*)smem;
    __syncthreads();
#pragma unroll
    for (int mi = 0; mi < MT; ++mi)
#pragma unroll
      for (int nj = 0; nj < NT; ++nj) {
        const int il = wi * MT * 16 + mi * 16 + fq * 4, jl = wj * NT * 16 + nj * 16 + fr;
        *(f32x4*)(sO + jl * 132 + il) = acc[mi][nj];
      }
    __syncthreads();
#pragma unroll
    for (int k = 0; k < 12; ++k) {
      const int c = tid + 256 * k, row = c >> 5, ch = c & 31, j = j0 + row, i = i0 + ch * 4;
      const f32x4 v = *(const f32x4*)(sO + row * 132 + ch * 4);
      float* hp = hrow(p, j) + i;
      const float* hin = (J.a == 0 && J.b == 2 * D && j < ML) ? p.in[0] + (size_t)j * D + i : hp;
      const float4 g = *(const float4*)(p.modv + (size_t)(J.a * 3 + mod_idx(j)) * 6144 + J.b + i);
      float4 hv = *(const float4*)hin;
      hv.x += g.x * v[0]; hv.y += g.y * v[1]; hv.z += g.z * v[2]; hv.w += g.w * v[3];
      *(float4*)hp = hv;
    }
    return;
  }
  float ldf2 = 0.f, ldb2 = 0.f;
  if (J.epi == EPI_RETP) { int h = (aux >> 6) & 3; ldf2 = p.in[28][h] * LOG2E; ldb2 = p.in[29][h] * LOG2E; }
#pragma unroll
  for (int mi = 0; mi < MT; ++mi)
#pragma unroll
    for (int nj = 0; nj < NT; ++nj) {
      const int i = i0 + wi * MT * 16 + mi * 16 + fq * 4, j = j0 + wj * NT * 16 + nj * 16 + fr;
      const f32x4 v = acc[mi][nj];
      if (J.epi == EPI_STORE) {
        if (i < J.a) *(uint2*)(J.o + (size_t)j * J.ld + i) = make_uint2(pack2(v[0], v[1]), pack2(v[2], v[3]));
      } else if (J.epi == EPI_VT) {
        int b, t; tok_bt(i, b, t);
        int hh = j >> J.a, dv = j & ((1 << J.a) - 1);
        *(uint2*)(J.o + ((size_t)((b * J.b + hh) << J.a) + dv) * TEXT + t) = make_uint2(pack2(v[0], v[1]), pack2(v[2], v[3]));
      } else if (J.epi == EPI_RESID) {
        float* hp = hrow(p, j) + i;
        const float4 g = *(const float4*)(p.modv + (size_t)(J.a * 3 + mod_idx(j)) * 6144 + J.b + i);
        float4 hv = *(float4*)hp;
        hv.x += g.x * v[0]; hv.y += g.y * v[1]; hv.z += g.z * v[2]; hv.w += g.w * v[3];
        *(float4*)hp = hv;
      } else if (J.epi == EPI_SWIGLU) {
        *(unsigned*)(J.o + (size_t)j * FH + (i >> 1)) = pack2(silu(v[0]) * v[1], silu(v[2]) * v[3]);
      } else {
        float pf[4], pb[4];
#pragma unroll
        for (int r = 0; r < 4; ++r) {
          int t = i + r, d = j - t;
          pf[r] = d >= 0 ? v[r] * ex2((float)d * ldf2) : 0.f;
          pb[r] = d <= 0 ? v[r] * ex2((float)(-d) * ldb2) : 0.f;
        }
        size_t off = ((size_t)aux * 128 + j) * 128 + i;
        *(uint2*)(J.o + off) = make_uint2(pack2(pf[0], pf[1]), pack2(pf[2], pf[3]));
        *(uint2*)(J.o + (size_t)512 * 128 * 128 + off) = make_uint2(pack2(pb[0], pb[1]), pack2(pb[2], pb[3]));
      }
    }
}

DI void gemm_phase(PRM p, int ph, char* smem) {
  int total = 0;
  for (int jj = 0; jj < 3; ++jj) { GJob J = make_job(p, ph, jj); total += J.nI * J.nJ; }
  const int G = gridDim.x, G8 = G >> 3, bid = get_bid();
  const int nround = (total + G - 1) / G;
  for (int r = 0; r < nround; ++r) {
    const int L = (r * 8 + (bid & 7)) * G8 + (bid >> 3);
    if (L >= total) continue;
    int t = L, jj = 0;
    GJob J = make_job(p, ph, 0);
    while (t >= J.nI * J.nJ) { t -= J.nI * J.nJ; ++jj; J = make_job(p, ph, jj); }
    if (J.epi == EPI_RETP) {
      int bh = t >> 6, chunk = t & 63, b = bh >> 2, h = bh & 3;
      size_t off = (size_t)(b * 8192 + chunk * 128) * 1024 + h * 256;
      gemm_core<4, 4, 64, 2>(p, J, J.P + off, J.Q + off, 0, 0, t, smem);
    } else {
      const int band = t / (BANDH * J.nI), rr = t % (BANDH * J.nI);
      const int hgt = min(BANDH, J.nJ - band * BANDH);
      const int ti = rr / hgt, tj = band * BANDH + rr % hgt;
      if (J.epi == EPI_RESID) gemm_core<4, 3, 64, 2>(p, J, J.P, J.Q, ti * 128, tj * 96, 0, smem);
      else gemm_core<8, 4, BIGBK, BIGDIST>(p, J, J.P, J.Q, ti * 256, tj * 128, 0, smem);
    }
  }
}

DI void phase_mla_post1(PRM p) {
  const int lane = get_tid() & 63, wave = get_tid() >> 6;
  const u16* raw = (const u16*)(p.arena + A0_RAW1);
  u16* cqn = (u16*)(p.arena + A0_CQN); u16* ckvn = (u16*)(p.arena + A0_CKVN);
  for (int m = get_bid() * 4 + wave; m < MALL; m += gridDim.x * 4) {
    const u16* r = raw + (size_t)m * 768;
    float q[6], k[4], sq = 0.f, sk = 0.f;
#pragma unroll
    for (int i = 0; i < 6; ++i) { q[i] = bf2f(r[lane + 64 * i]); sq += q[i] * q[i]; }
#pragma unroll
    for (int i = 0; i < 4; ++i) { k[i] = bf2f(r[384 + lane + 64 * i]); sk += k[i] * k[i]; }
    sq = wave_sum(sq); sk = wave_sum(sk);
    float rq = rsqrtf(sq * (1.f / 384.f) + EPS), rk = rsqrtf(sk * (1.f / 256.f) + EPS);
#pragma unroll
    for (int i = 0; i < 6; ++i) cqn[(size_t)m * 384 + lane + 64 * i] = f2bf(q[i] * rq * p.in[11][lane + 64 * i]);
#pragma unroll
    for (int i = 0; i < 4; ++i) ckvn[(size_t)m * 256 + lane + 64 * i] = f2bf(k[i] * rk * p.in[12][lane + 64 * i]);
  }
}
DI void phase_mla_post2(PRM p) {
  const int lane = get_tid() & 63, wave = get_tid() >> 6;
  const u16* raw1 = (const u16*)(p.arena + A0_RAW1);
  const u16* qraw = (const u16*)(p.arena + A0_QRAW);
  const u16* knraw = (const u16*)(p.arena + A0_KNRAW);
  u16* Qf = (u16*)(p.arena + A0_Q); u16* Kf = (u16*)(p.arena + A0_K);
  const int nitems = MALL * 16, stride = gridDim.x * 4;
  const float gq0 = p.in[15][lane], gq1 = p.in[15][lane + 64], gq2 = p.in[15][lane + 128];
  const float gk0 = p.in[16][lane], gk1 = p.in[16][lane + 64], gk2 = p.in[16][lane + 128];
  for (int it0 = get_bid() * 4 + wave; it0 < nitems; it0 += 4 * stride) {
    u16 rv[4][3];
#pragma unroll
    for (int u = 0; u < 4; ++u) {
      const int it = it0 + u * stride;
      rv[u][0] = rv[u][1] = rv[u][2] = 0;
      if (it < nitems) {
        const int m = it >> 4, hh = it & 15, isk = hh >> 3, h = hh & 7;
        if (!isk) {
          const u16* s = qraw + (size_t)m * 1536 + h * 192;
          rv[u][0] = s[lane]; rv[u][1] = s[lane + 64]; rv[u][2] = s[lane + 128];
        } else {
          const u16* s = knraw + (size_t)m * 1024 + h * 128;
          rv[u][0] = s[lane]; rv[u][1] = s[lane + 64]; rv[u][2] = raw1[(size_t)m * 768 + 640 + lane];
        }
      }
    }
#pragma unroll
    for (int u = 0; u < 4; ++u) {
      const int it = it0 + u * stride;
      if (it < nitems) {
        const int m = it >> 4, hh = it & 15, isk = hh >> 3, h = hh & 7;
        float v0 = bf2f(rv[u][0]), v1 = bf2f(rv[u][1]), v2 = bf2f(rv[u][2]);
        float ss = wave_sum(v0 * v0 + v1 * v1 + v2 * v2);
        float r = rsqrtf(ss * (1.f / 192.f) + EPS);
        v0 *= r * (isk ? gk0 : gq0); v1 *= r * (isk ? gk1 : gq1); v2 *= r * (isk ? gk2 : gq2);
        float partner = __shfl_xor(v2, 32);
        if (m < ML) {
          int sq = m & 8191, pr = lane & 31;
          int pos = pr < 16 ? (sq >> 6) : (sq & 63);
          float2 cs = p.tab[pos * 16 + (pr & 15)];
          v2 = lane < 32 ? v2 * cs.x - partner * cs.y : partner * cs.y + v2 * cs.x;
        }
        u16* d;
        if (!isk) d = Qf + (size_t)m * 1536 + h * 192;
        else { int b, t; tok_bt(m, b, t); d = Kf + ((size_t)(b * 8 + h) * TEXT + t) * 192; }
        d[lane] = f2bf(v0); d[lane + 64] = f2bf(v1); d[lane + 128] = f2bf(v2);
      }
    }
  }
}
DI void phase_gqa_post(PRM p) {
  const int lane = get_tid() & 63, wave = get_tid() >> 6;
  const u16* raw = (const u16*)(p.arena + A1_RAW);
  u16* Qf = (u16*)(p.arena + A1_Q); u16* Kf = (u16*)(p.arena + A1_K);
  const int nitems = MALL * 10, stride = gridDim.x * 4;
  const float gq0 = p.in[19][lane], gq1 = p.in[19][lane + 64], gk0 = p.in[20][lane], gk1 = p.in[20][lane + 64];
  for (int it0 = get_bid() * 4 + wave; it0 < nitems; it0 += 4 * stride) {
    u16 rv[4][2];
#pragma unroll
    for (int u = 0; u < 4; ++u) {
      const int it = it0 + u * stride;
      rv[u][0] = rv[u][1] = 0;
      if (it < nitems) {
        const int m = it / 10, hh = it % 10;
        const u16* s = raw + (size_t)m * 1280 + hh * 128;
        rv[u][0] = s[lane]; rv[u][1] = s[lane + 64];
      }
    }
#pragma unroll
    for (int u = 0; u < 4; ++u) {
      const int it = it0 + u * stride;
      if (it < nitems) {
        const int m = it / 10, hh = it % 10, isk = hh >= 8;
        float x1 = bf2f(rv[u][0]), x2 = bf2f(rv[u][1]);
        float ss = wave_sum(x1 * x1 + x2 * x2);
        float r = rsqrtf(ss * (1.f / 128.f) + EPS);
        x1 *= r * (isk ? gk0 : gq0); x2 *= r * (isk ? gk1 : gq1);
        if (m < ML) {
          int sq = m & 8191;
          int pos = lane < 32 ? (sq >> 6) : (sq & 63);
          float2 cs = p.tab[2048 + pos * 32 + (lane & 31)];
          float y1 = x1 * cs.x - x2 * cs.y, y2 = x1 * cs.y + x2 * cs.x;
          x1 = y1; x2 = y2;
        }
        u16* d;
        if (!isk) d = Qf + (size_t)m * 1024 + hh * 128;
        else { int b, t; tok_bt(m, b, t); d = Kf + ((size_t)(b * 2 + (hh - 8)) * TEXT + t) * 128; }
        d[lane] = f2bf(x1); d[lane + 64] = f2bf(x2);
      }
    }
  }
}
DI void phase_na_post(PRM p) {
  const int lane = get_tid() & 63, wave = get_tid() >> 6;
  const u16* raw = (const u16*)(p.arena + A2_RAW);
  u16* Qf = (u16*)(p.arena + A2_Q); u16* Kf = (u16*)(p.arena + A2_K);
  const int stride = gridDim.x * 4;
  float gq[8], gk[8];
#pragma unroll
  for (int j = 0; j < 8; ++j) { gq[j] = p.in[23][(lane & 7) * 8 + j]; gk[j] = p.in[24][(lane & 7) * 8 + j]; }
  for (int m = get_bid() * 4 + wave; m < MALL; m += stride) {
    u32x4 rv[4];
#pragma unroll
    for (int ps = 0; ps < 4; ++ps) rv[ps] = *(const u32x4*)(raw + (size_t)m * 2048 + ps * 512 + lane * 8);
    int b, t; tok_bt(m, b, t);
#pragma unroll
    for (int ps = 0; ps < 4; ++ps) {
      float f[8]; float ss = 0.f;
#pragma unroll
      for (int j = 0; j < 4; ++j) { f[2 * j] = __uint_as_float(rv[ps][j] << 16); f[2 * j + 1] = __uint_as_float(rv[ps][j] & 0xffff0000u); }
#pragma unroll
      for (int j = 0; j < 8; ++j) ss += f[j] * f[j];
      ss += __shfl_xor(ss, 1); ss += __shfl_xor(ss, 2); ss += __shfl_xor(ss, 4);
      const float r = rsqrtf(ss * (1.f / 64.f) + EPS);
      const bool isk = ps >= 2;
      unsigned w[4];
#pragma unroll
      for (int j = 0; j < 4; ++j) w[j] = pack2(f[2 * j] * r * (isk ? gk[2 * j] : gq[2 * j]), f[2 * j + 1] * r * (isk ? gk[2 * j + 1] : gq[2 * j + 1]));
      const int e = (ps & 1) * 512 + lane * 8, h = e >> 6;
      u16* d = isk ? Kf + ((size_t)(b * 16 + h) * TEXT + t) * 64 + (e & 63) : Qf + (size_t)m * 1024 + e;
      *(u32x4*)d = (u32x4){w[0], w[1], w[2], w[3]};
    }
  }
}
DI void phase_ret_post(PRM p, char* smem) {
  const int tid = get_tid(), lane = tid & 63, wave = tid >> 6;
  const u16* raw = (const u16*)(p.arena + A3_RAW);
  u16* Qf = p.xn; u16* Kn = (u16*)(p.arena + A3_KN); u16* KT = (u16*)(p.arena + A3_KT);
  {
    const int stride = gridDim.x * 4, nitems = ML * 4;
    for (int it0 = get_bid() * 4 + wave; it0 < nitems; it0 += 4 * stride) {
      u16 rv[4][4];
#pragma unroll
      for (int k = 0; k < 4; ++k) {
        const int it = it0 + k * stride;
        rv[k][0] = rv[k][1] = rv[k][2] = rv[k][3] = 0;
        if (it < nitems) {
          const u16* s = raw + (size_t)(it >> 2) * 2048 + (it & 3) * 256;
          rv[k][0] = s[lane]; rv[k][1] = s[lane + 64]; rv[k][2] = s[lane + 128]; rv[k][3] = s[lane + 192];
        }
      }
#pragma unroll
      for (int k = 0; k < 4; ++k) {
        const int it = it0 + k * stride;
        if (it < nitems) {
          const int m = it >> 2, h = it & 3, sq = m & 8191;
          float a1 = bf2f(rv[k][0]), b1 = bf2f(rv[k][1]), a2 = bf2f(rv[k][2]), b2 = bf2f(rv[k][3]);
          float2 ca = p.tab[6144 + (sq >> 6) * 64 + lane], cb = p.tab[6144 + (sq & 63) * 64 + lane];
          u16* d = Qf + (size_t)m * 1024 + h * 256;
          d[lane] = f2bf(a1 * ca.x - a2 * ca.y); d[lane + 128] = f2bf(a1 * ca.y + a2 * ca.x);
          d[lane + 64] = f2bf(b1 * cb.x - b2 * cb.y); d[lane + 192] = f2bf(b1 * cb.y + b2 * cb.x);
        }
      }
    }
  }
  u16* sT = (u16*)smem;
  for (int it = get_bid(); it < 264 * 4; it += gridDim.x) {
    const int tb = it >> 2, h = it & 3, m0 = tb * 64;
    __syncthreads();
    for (int t4 = 0; t4 < 16; t4 += 4) {
      u16 rv[4][4];
#pragma unroll
      for (int k = 0; k < 4; ++k) {
        const u16* s = raw + (size_t)(m0 + wave * 16 + t4 + k) * 2048 + 1024 + h * 256;
        rv[k][0] = s[lane]; rv[k][1] = s[lane + 64]; rv[k][2] = s[lane + 128]; rv[k][3] = s[lane + 192];
      }
#pragma unroll
      for (int k = 0; k < 4; ++k) {
        const int tl = wave * 16 + t4 + k, m = m0 + tl;
        float a1 = bf2f(rv[k][0]) * 0.0625f, b1 = bf2f(rv[k][1]) * 0.0625f, a2 = bf2f(rv[k][2]) * 0.0625f, b2 = bf2f(rv[k][3]) * 0.0625f;
        if (m < ML) {
          int sq = m & 8191;
          float2 ca = p.tab[6144 + (sq >> 6) * 64 + lane], cb = p.tab[6144 + (sq & 63) * 64 + lane];
          float y1 = a1 * ca.x - a2 * ca.y, y2 = a1 * ca.y + a2 * ca.x, z1 = b1 * cb.x - b2 * cb.y, z2 = b1 * cb.y + b2 * cb.x;
          a1 = y1; a2 = y2; b1 = z1; b2 = z2;
        }
        u16 o0 = f2bf(a1), o1 = f2bf(b1), o2 = f2bf(a2), o3 = f2bf(b2);
        if (m < ML) { u16* d = Kn + (size_t)m * 1024 + h * 256; d[lane] = o0; d[lane + 64] = o1; d[lane + 128] = o2; d[lane + 192] = o3; }
        u16* r = sT + tl * 258; r[lane] = o0; r[lane + 64] = o1; r[lane + 128] = o2; r[lane + 192] = o3;
      }
    }
    __syncthreads();
    int b, t0; tok_bt(m0, b, t0);
#pragma unroll
    for (int i = 0; i < 8; ++i) {
      int c = tid + 256 * i, k = c & 255, tc = c >> 8;
      u16 e[8];
#pragma unroll
      for (int j = 0; j < 8; ++j) e[j] = sT[(tc * 8 + j) * 258 + k];
      uint4 pk = make_uint4(e[0] | ((unsigned)e[1] << 16), e[2] | ((unsigned)e[3] << 16), e[4] | ((unsigned)e[5] << 16), e[6] | ((unsigned)e[7] << 16));
      *(uint4*)(KT + ((size_t)((b * 4 + h) * 256 + k)) * TEXT + t0 + tc * 8) = pk;
    }
  }
  __syncthreads();
}
DI void phase_ret_gate(PRM p) {
  const int lane = get_tid() & 63, wave = get_tid() >> 6;
  const u16* y = (const u16*)(p.arena + A3_Y); const u16* g = (const u16*)(p.arena + A3_G); u16* u = (u16*)(p.arena + A3_U);
  const int stride = gridDim.x * 4, nitems = ML * 4;
  for (int it0 = get_bid() * 4 + wave; it0 < nitems; it0 += 4 * stride) {
    u32x4 yv[4], gv[4];
#pragma unroll
    for (int k = 0; k < 4; ++k) {
      const int it = it0 + k * stride;
      yv[k] = (u32x4){0u, 0u, 0u, 0u}; gv[k] = yv[k];
      if (it < nitems) {
        const size_t off = (size_t)(it >> 2) * 2048 + (it & 3) * 512 + lane * 8;
        yv[k] = *(const u32x4*)(y + off); gv[k] = *(const u32x4*)(g + off);
      }
    }
#pragma unroll
    for (int k = 0; k < 4; ++k) {
      const int it = it0 + k * stride;
      if (it < nitems) {
        const int h = it & 3;
        const size_t off = (size_t)(it >> 2) * 2048 + h * 512 + lane * 8;
        float f[8], gg[8], s = 0.f;
#pragma unroll
        for (int i = 0; i < 4; ++i) {
          f[2 * i] = __uint_as_float(yv[k][i] << 16); f[2 * i + 1] = __uint_as_float(yv[k][i] & 0xffff0000u);
          gg[2 * i] = __uint_as_float(gv[k][i] << 16); gg[2 * i + 1] = __uint_as_float(gv[k][i] & 0xffff0000u);
        }
#pragma unroll
        for (int i = 0; i < 8; ++i) s += f[i];
        float mu = wave_sum(s) * (1.f / 512.f), vs = 0.f;
#pragma unroll
        for (int i = 0; i < 8; ++i) { f[i] -= mu; vs += f[i] * f[i]; }
        float r = rsqrtf(wave_sum(vs) * (1.f / 512.f) + EPS);
        const float* on = p.in[30] + h * 512 + lane * 8;
        float o[8];
#pragma unroll
        for (int i = 0; i < 8; ++i) o[i] = f[i] * r * on[i] * silu(gg[i]);
        *(u32x4*)(u + off) = (u32x4){pack2(o[0], o[1]), pack2(o[2], o[3]), pack2(o[4], o[5]), pack2(o[6], o[7])};
      }
    }
  }
}

template <int DQK, int DV, bool NA, int KT>
DI void attn_phase(PRM p, const u16* Qf, const u16* Kf, const u16* VT, u16* O, int H, int KVH, float scale, const float* rpb,
                   bool do_lat, bool do_ctx, char* smem) {
  constexpr int KST = DQK + 8, VST = KT + 4, NKC = KT * DQK / 2048, NVC = DV * KT / 2048, KCH = DQK / 8, VCH = KT / 8, NKB = KT / 32, KR = KCH / 8, NDVB = DV / 32;
  const int tid = get_tid(), lane = tid & 63, wave = tid >> 6, hh = lane >> 5, ql = lane & 31;
  u16* sK = (u16*)smem; u16* sV = sK + KT * KST; float* sB = (float*)(sV + DV * VST);
  const int G = H / KVH;
  const int t_lo = do_lat ? 0 : 128 * H, t_hi = do_ctx ? 132 * H : 128 * H;
  const float sl2 = scale * LOG2E;
  const int kgo = (tid >> 3) * DQK + (tid & 7) * 8, kso = (tid >> 3) * KST + (tid & 7) * 8;
  const int vgo = (tid / VCH) * TEXT + (tid % VCH) * 8, vso = (tid / VCH) * VST + (tid % VCH) * 8;
  for (int tile = t_lo + get_bid(); tile < t_hi; tile += gridDim.x) {
    const int h = tile % H, mt = tile / H;
    const bool isctx = mt >= 128;
    const int m0 = isctx ? ML + (mt - 128) * 128 : mt * 128;
    const int b = isctx ? (mt - 128) >> 1 : mt >> 6;
    const int kvh = h / G;
    const u16* Kg = Kf + (size_t)(b * KVH + kvh) * TEXT * DQK;
    const u16* Vg = VT + (size_t)(b * KVH + kvh) * DV * TEXT;
    const int qrow = m0 + wave * 32 + ql;
    bf16x8 qf[DQK / 16];
#pragma unroll
    for (int kk = 0; kk < DQK / 16; ++kk) qf[kk] = *(const bf16x8*)(Qf + (size_t)qrow * (H * DQK) + h * DQK + kk * 16 + hh * 8);
    int nkt = isctx ? 256 / KT : TEXT / KT, rbase = 0, qr = 0, r0q = 0;
    if (NA) {
      int s0 = m0 & 8191, r1 = s0 >> 6;
      rbase = clampi(r1 - 4, 0, 120);
      nkt = 4 + (clampi(r1 + 1 - 4, 0, 120) + 8 - rbase);
      qr = (s0 + wave * 32) >> 6; r0q = clampi(qr - 4, 0, 120);
    }
    __syncthreads();
    if (NA) { for (int i = tid; i < 465; i += 256) sB[i] = rpb[h * 465 + i] * LOG2E; }
    f32x16 o[NDVB];
#pragma unroll
    for (int i = 0; i < NDVB; ++i)
#pragma unroll
      for (int j = 0; j < 16; ++j) o[i][j] = 0.f;
    float mrun = -1e30f, lrun = 0.f;
    u32x4 kr[NKC], vr[NVC];
    {
      const int t0 = 0;
#pragma unroll
      for (int i = 0; i < NKC; ++i) kr[i] = *(const u32x4*)(Kg + (unsigned)(t0 * DQK + kgo + 32 * (i / KR) * DQK + 64 * (i % KR)));
#pragma unroll
      for (int i = 0; i < NVC; ++i) vr[i] = *(const u32x4*)(Vg + (unsigned)(t0 + vgo + i * (256 / VCH) * TEXT));
    }
    for (int it = 0; it < nkt; ++it) {
      __syncthreads();
#pragma unroll
      for (int i = 0; i < NKC; ++i) *(u32x4*)(sK + kso + 32 * (i / KR) * KST + 64 * (i % KR)) = kr[i];
#pragma unroll
      for (int i = 0; i < NVC; ++i) {
        *(u32x2*)(sV + vso + i * (256 / VCH) * VST) = (u32x2){vr[i][0], vr[i][1]};
        *(u32x2*)(sV + vso + i * (256 / VCH) * VST + 4) = (u32x2){vr[i][2], vr[i][3]};
      }
      __syncthreads();
      if (it + 1 < nkt) {
        const int itn = it + 1;
        const int t0 = (NA && itn >= 4) ? 256 + (rbase + itn - 4) * 64 : itn * KT;
#pragma unroll
        for (int i = 0; i < NKC; ++i) kr[i] = *(const u32x4*)(Kg + (unsigned)(t0 * DQK + kgo + 32 * (i / KR) * DQK + 64 * (i % KR)));
#pragma unroll
        for (int i = 0; i < NVC; ++i) vr[i] = *(const u32x4*)(Vg + (unsigned)(t0 + vgo + i * (256 / VCH) * TEXT));
      }
      const int krow = rbase + it - 4;
      const bool local = NA && it >= 4;
      if (local && !(krow >= r0q && krow < r0q + 8)) continue;
      f32x16 s[NKB];
#pragma unroll
      for (int kb = 0; kb < NKB; ++kb)
#pragma unroll
        for (int j = 0; j < 16; ++j) s[kb][j] = 0.f;
      {
        constexpr int NKK = DQK / 16, NQK = NKB * NKK, RD = (DQK > 128 && KT == 64) ? 2 : 4;
        bf16x8 kf[NQK];
#define LDK(i) (*(const bf16x8*)(sK + (((i) / NKK) * 32 + ql) * KST + ((i) % NKK) * 16 + hh * 8))
#pragma unroll
        for (int i = 0; i < RD; ++i) kf[i] = LDK(i);
        __builtin_amdgcn_sched_barrier(0);
#pragma unroll
        for (int i = 0; i < NQK; ++i) {
          if (i + RD < NQK) kf[i + RD] = LDK(i + RD);
          s[i / NKK] = MFMA32(kf[i], qf[i % NKK], s[i / NKK]);
          __builtin_amdgcn_sched_barrier(0);
        }
#undef LDK
      }
      float mloc = -1e30f;
      if (local) {
        const int qc = (wave & 1) * 32 + ql, csq = clampi(qc - 8, 0, 48);
        const int bro = (krow - qr + 7) * 31 - qc + 15;
#pragma unroll
        for (int kb = 0; kb < NKB; ++kb)
#pragma unroll
          for (int i = 0; i < 16; ++i) {
            int kc = kb * 32 + (i & 3) + 8 * (i >> 2) + 4 * hh;
            bool ok = kc >= csq && kc < csq + 16;
            float x = ok ? s[kb][i] * sl2 + sB[bro + kc] : -1e30f;
            s[kb][i] = x; mloc = fmaxf(mloc, x);
          }
      } else {
#pragma unroll
        for (int kb = 0; kb < NKB; ++kb)
#pragma unroll
          for (int i = 0; i < 16; ++i) mloc = fmaxf(mloc, s[kb][i]);
        mloc *= sl2;
      }
      mloc = fmaxf(mloc, __shfl_xor(mloc, 32));
      const float mnew = fmaxf(mrun, mloc);
      if (__any(mnew > mrun)) {
        const float alpha = ex2(mrun - mnew);
        mrun = mnew;
        lrun *= alpha;
#pragma unroll
        for (int i = 0; i < NDVB; ++i)
#pragma unroll
          for (int j = 0; j < 16; ++j) o[i][j] *= alpha;
      }
      float ls = 0.f;
      if (local) {
#pragma unroll
        for (int kb = 0; kb < NKB; ++kb)
#pragma unroll
          for (int i = 0; i < 16; ++i) { float e = ex2(s[kb][i] - mrun); s[kb][i] = e; ls += e; }
      } else {
        const float nm = -mrun;
#pragma unroll
        for (int kb = 0; kb < NKB; ++kb)
#pragma unroll
          for (int i = 0; i < 16; ++i) { float e = ex2(fmaf(s[kb][i], sl2, nm)); s[kb][i] = e; ls += e; }
      }
      lrun += ls;
      {
        constexpr int NPV = NKB * 2 * NDVB, RD = (DQK > 128 && KT == 64) ? 2 : 4;
        bf16x8 pf[NKB * 2], vf[NPV];
#pragma unroll
        for (int c = 0; c < NKB * 2; ++c) {
          const int kb = c >> 1, st = c & 1;
          u32x4 pw = {pack2(s[kb][8 * st], s[kb][8 * st + 1]), pack2(s[kb][8 * st + 2], s[kb][8 * st + 3]),
                      pack2(s[kb][8 * st + 4], s[kb][8 * st + 5]), pack2(s[kb][8 * st + 6], s[kb][8 * st + 7])};
          pf[c] = __builtin_bit_cast(bf16x8, pw);
        }
#define LDV(j) ({ const u16* vp_ = sV + (((j) % NDVB) * 32 + ql) * VST + ((j) / NDVB) * 16 + hh * 4; \
                  bf16x4 lo_ = *(const bf16x4*)vp_, hi_ = *(const bf16x4*)(vp_ + 8); __builtin_shufflevector(lo_, hi_, 0, 1, 2, 3, 4, 5, 6, 7); })
#pragma unroll
        for (int j = 0; j < RD; ++j) vf[j] = LDV(j);
        __builtin_amdgcn_sched_barrier(0);
#pragma unroll
        for (int j = 0; j < NPV; ++j) {
          if (j + RD < NPV) vf[j + RD] = LDV(j + RD);
          o[j % NDVB] = MFMA32(vf[j], pf[j / NDVB], o[j % NDVB]);
          __builtin_amdgcn_sched_barrier(0);
        }
#undef LDV
      }
    }
    lrun += __shfl_xor(lrun, 32);
    const float inv = 1.f / lrun;
#pragma unroll
    for (int dvb = 0; dvb < NDVB; ++dvb)
#pragma unroll
      for (int g = 0; g < 4; ++g) {
        int dv = dvb * 32 + 8 * g + 4 * hh;
        *(uint2*)(O + (size_t)qrow * (H * DV) + h * DV + dv) =
            make_uint2(pack2(o[dvb][4 * g] * inv, o[dvb][4 * g + 1] * inv), pack2(o[dvb][4 * g + 2] * inv, o[dvb][4 * g + 3] * inv));
      }
  }
}

DI void phase_ret_scan(PRM p, char* smem) {
  const int tid = get_tid(), lane = tid & 63, wave = tid >> 6, fr = lane & 15, fq = lane >> 4;
  u16* sST = (u16*)smem;
  float* sKD = (float*)(smem + 16896);
  const unsigned vlo = fr * TEXT + fq * 8;
  const unsigned klo = (wave * 64 + fr) * TEXT + fq * 8;
  const unsigned plo = (wave * 32 + fr) * 128 + fq * 8;
  const unsigned qlo = (wave * 32 + fr) * 1024 + fq * 8;
  const unsigned ylo = (wave * 32 + fr) * 2048 + fq * 4;
  for (int item = get_bid(); item < 256; item += gridDim.x) {
    const int bh = item & 7, slice = item >> 3, b = bh >> 2, h = bh & 3, v0 = slice * 16;
    const float ld2[2] = {p.in[28][h] * LOG2E, p.in[29][h] * LOG2E};
    const u16* VTb = (const u16*)(p.arena + A3_VT) + (size_t)(bh * 512 + v0) * TEXT;
    const u16* KTb = (const u16*)(p.arena + A3_KT) + (size_t)(bh * 256) * TEXT;
    f32x4 S[2][4];
#pragma unroll
    for (int d = 0; d < 2; ++d)
#pragma unroll
      for (int r = 0; r < 4; ++r) S[d][r] = (f32x4){0.f, 0.f, 0.f, 0.f};
    __syncthreads();
    sKD[tid] = tid < 128 ? ex2((float)(127 - tid) * ld2[0]) : ex2((float)(tid - 128) * ld2[1]);
    __syncthreads();
    for (int st = 0; st < 66; ++st) {
#pragma unroll
      for (int d = 0; d < 2; ++d) {
        float l2 = ld2[d];
        asm volatile("" : "+v"(l2));
        int text0, n = 0;
        if (st < 2) text0 = (d == 0 ? st : 1 - st) * 128;
        else { n = d == 0 ? st - 2 : 63 - (st - 2); text0 = 256 + n * 128; }
        bf16x8 vfr[4], kfr[4][4];
#pragma unroll
        for (int ks = 0; ks < 4; ++ks) vfr[ks] = *(const bf16x8*)(VTb + (vlo + text0 + ks * 32));
        if (st >= 2) {
          const int mrow = b * 8192 + n * 128;
          const bool first = (st - 2) < 32;
          const u16* Pb = (const u16*)(p.arena + A3_P) + (size_t)d * 512 * 128 * 128 + (size_t)(bh * 64 + n) * 16384;
          const u16* Qb = p.xn + (size_t)mrow * 1024 + h * 256;
          u16* Yb = (u16*)(p.arena + A3_Y) + (size_t)mrow * 2048 + h * 512 + v0;
#pragma unroll 1
          for (int ot = 0; ot < 2; ++ot) {
            f32x4 ain = (f32x4){0.f, 0.f, 0.f, 0.f}, acr = (f32x4){0.f, 0.f, 0.f, 0.f};
            bf16x8 pa[4], qa[8];
#pragma unroll
            for (int ks = 0; ks < 4; ++ks) pa[ks] = *(const bf16x8*)(Pb + (plo + ot * 16 * 128 + ks * 32));
#pragma unroll
            for (int ks = 0; ks < 8; ++ks) qa[ks] = *(const bf16x8*)(Qb + (qlo + ot * 16 * 1024 + ks * 32));
            u32x2 yw = *(const u32x2*)(Yb + (ylo + ot * 16 * 2048));
            if (first) yw = (u32x2){0u, 0u};
            f32x4 yold;
            yold[0] = __uint_as_float(yw[0] << 16); yold[1] = __uint_as_float(yw[0] & 0xffff0000u);
            yold[2] = __uint_as_float(yw[1] << 16); yold[3] = __uint_as_float(yw[1] & 0xffff0000u);
#pragma unroll
            for (int ks = 0; ks < 4; ++ks) ain = MFMA16(vfr[ks], pa[ks], ain);
#pragma unroll
            for (int ks = 0; ks < 8; ++ks) {
              bf16x8 bb = *(const bf16x8*)(sST + (d * 16 + fr) * 264 + ks * 32 + fq * 8);
              acr = MFMA16(bb, qa[ks], acr);
            }
            {
              const int q = wave * 32 + ot * 16 + fr;
              const float qd = d == 0 ? ex2((float)(q + 1) * l2) : ex2((float)(128 - q) * l2);
              *(u32x2*)(Yb + (ylo + ot * 16 * 2048)) = (u32x2){pack2(ain[0] + acr[0] * qd + yold[0], ain[1] + acr[1] * qd + yold[1]),
                                                              pack2(ain[2] + acr[2] * qd + yold[2], ain[3] + acr[3] * qd + yold[3])};
            }
          }
        }
#pragma unroll
        for (int rt = 0; rt < 4; ++rt)
#pragma unroll
          for (int ks = 0; ks < 4; ++ks) kfr[rt][ks] = *(const bf16x8*)(KTb + (klo + rt * 16 * TEXT + text0 + ks * 32));
        const float cd = ex2(128.f * l2);
#pragma unroll
        for (int ks = 0; ks < 4; ++ks) {
          unsigned w[4];
          const f32x4 k0 = *(const f32x4*)(sKD + d * 128 + ks * 32 + fq * 8), k1 = *(const f32x4*)(sKD + d * 128 + ks * 32 + fq * 8 + 4);
          w[0] = pack2(bf2f((u16)vfr[ks][0]) * k0[0], bf2f((u16)vfr[ks][1]) * k0[1]);
          w[1] = pack2(bf2f((u16)vfr[ks][2]) * k0[2], bf2f((u16)vfr[ks][3]) * k0[3]);
          w[2] = pack2(bf2f((u16)vfr[ks][4]) * k1[0], bf2f((u16)vfr[ks][5]) * k1[1]);
          w[3] = pack2(bf2f((u16)vfr[ks][6]) * k1[2], bf2f((u16)vfr[ks][7]) * k1[3]);
          vfr[ks] = __builtin_bit_cast(bf16x8, (u32x4){w[0], w[1], w[2], w[3]});
        }
#pragma unroll
        for (int rt = 0; rt < 4; ++rt) {
          S[d][rt] *= cd;
#pragma unroll
          for (int ks = 0; ks < 4; ++ks) S[d][rt] = MFMA16(kfr[rt][ks], vfr[ks], S[d][rt]);
        }
        __builtin_amdgcn_sched_barrier(0);
      }
      __syncthreads();
#pragma unroll
      for (int d = 0; d < 2; ++d)
#pragma unroll
        for (int rt = 0; rt < 4; ++rt)
          *(uint2*)(sST + (d * 16 + fr) * 264 + wave * 64 + rt * 16 + fq * 4) = make_uint2(pack2(S[d][rt][0], S[d][rt][1]), pack2(S[d][rt][2], S[d][rt][3]));
      __syncthreads();
    }
  }
}

#define XB_TMO      128
#define XB_XCNT(j)  (256  + 64 * (j))
#define XB_XSUB(j)  (1280 + 64 * (j))
#define XB_XGEN(j)  (2304 + 64 * (j))
#define XB_TOP      3328
#define XB_TOPGEN   3392
#define XCD_BAR_WORDS 3456
#define XB_SPIN_CAP (1u << 18)
#define LAS __attribute__((address_space(3)))

__device__ __forceinline__ unsigned xb_ld(unsigned* p)              { return __hip_atomic_load(p, __ATOMIC_RELAXED, __HIP_MEMORY_SCOPE_AGENT); }
__device__ __forceinline__ unsigned xb_add(unsigned* p, unsigned v) { return __hip_atomic_fetch_add(p, v, __ATOMIC_RELAXED, __HIP_MEMORY_SCOPE_AGENT); }
__device__ __forceinline__ unsigned xb_xcc_id() { return (unsigned)__builtin_amdgcn_s_getreg((3 << 11) | 20) & 0xFu; }
#define XB_SPIN(cond, bar) do { unsigned _sp = 0; while (cond) { __builtin_amdgcn_s_sleep(1); \
    if ((++_sp & 255u) == 0u) { if (xb_ld(&(bar)[XB_TMO])) break; if (_sp > XB_SPIN_CAP) { atomicAdd(&(bar)[XB_TMO], 1u); break; } } } } while (0)

struct XcdBarrier {
    unsigned* bar; unsigned x;
    volatile LAS unsigned* st;
};

__device__ __forceinline__ XcdBarrier xcd_barrier_post(unsigned* bar, volatile LAS unsigned* st) {
    XcdBarrier b; b.bar = bar; b.x = xb_xcc_id(); b.st = st;
    if (threadIdx.x == 0) (void)xb_add(&bar[XB_XCNT(b.x)], 1u);
    return b;
}
__device__ __forceinline__ void xcd_barrier_complete(unsigned* bar, unsigned x, unsigned& nloc, unsigned& nx) {
    const unsigned G = gridDim.x * gridDim.y * gridDim.z;
    unsigned sum, cnt, mine, sp = 0u;
    for (;;) {
        sum = 0u; cnt = 0u; mine = 0u;
#pragma unroll
        for (unsigned j = 0; j < 16; ++j) { const unsigned c = xb_ld(&bar[XB_XCNT(j)]); sum += c; cnt += (c > 0u) ? 1u : 0u; mine = (j == x) ? c : mine; }
        if (sum == G) break;
        __builtin_amdgcn_s_sleep(1);
        if ((++sp & 255u) == 0u) { if (xb_ld(&bar[XB_TMO])) break; if (sp > XB_SPIN_CAP) { atomicAdd(&bar[XB_TMO], 1u); break; } }
    }
    nloc = mine > 0u ? mine : 1u; nx = cnt > 0u ? cnt : 1u;
}

__device__ __forceinline__ void xcd_barrier(const XcdBarrier& b) {
    asm volatile("s_waitcnt vmcnt(0)" ::: "memory");
    __syncthreads();
    if (threadIdx.x == 0) {
        unsigned* bar = b.bar;
        __builtin_amdgcn_s_waitcnt(0);
        unsigned nloc = b.st[0], nx = b.st[1];
        if (nloc == 0u) { xcd_barrier_complete(bar, b.x, nloc, nx); b.st[0] = nloc; b.st[1] = nx; }
        const unsigned old = xb_add(&bar[XB_XSUB(b.x)], 1u);
        const unsigned gen = old / nloc;
        if (old + 1u == (gen + 1u) * nloc) {
            __builtin_amdgcn_fence(__ATOMIC_RELEASE, "agent");
            asm volatile("s_waitcnt vmcnt(0)" ::: "memory");
            const unsigned og = xb_add(&bar[XB_TOP], 1u);
            const unsigned tg = og / nx;
            if (og + 1u == (tg + 1u) * nx) xb_add(&bar[XB_TOPGEN], 1u);
            else XB_SPIN(xb_ld(&bar[XB_TOPGEN]) == tg, bar);
            __builtin_amdgcn_fence(__ATOMIC_ACQUIRE, "agent");
            xb_add(&bar[XB_XGEN(b.x)], 1u);
            asm volatile("s_waitcnt vmcnt(0)" ::: "memory");
        } else {
            XB_SPIN(xb_ld(&bar[XB_XGEN(b.x)]) == gen, bar);
            __builtin_amdgcn_fence(__ATOMIC_ACQUIRE, "agent");
            asm volatile("s_waitcnt vmcnt(0)" ::: "memory");
        }
    }
    __syncthreads();
}


__global__ void __launch_bounds__(256, 2) fwd_megakernel(Params p_unused) {
  typedef const __attribute__((address_space(4))) Params CParams;
  __shared__ __attribute__((aligned(16))) char smem[61440];
  cg::grid_group grid = cg::this_grid();
  int rep = 0;
  CParams* pp0 = (CParams*)__builtin_amdgcn_kernarg_segment_ptr();
  __shared__ uint4 xb_words;
  if (threadIdx.x == 0) xb_words = make_uint4(0u, 0u, 0u, 0u);
  __syncthreads();
  XcdBarrier xb = xcd_barrier_post(pp0->bar, (volatile LAS unsigned*)&xb_words);
  const int ph_lo = pp0->phase_lo, ph_hi = pp0->phase_hi;
  for (int ph = ph_lo; ph < ph_hi; ++ph) {
    CParams* pp = pp0;
    asm volatile("" : "+s"(pp));
    PRM p = *pp;
    switch (ph) {
      case 0: phase_init(p, smem); break;
      case 1: phase_norm(p, 0, 0, MALL); break;
      case 11: convert_layer(p, 1, smem); phase_norm(p, 1, 0, MALL); break;
      case 19: convert_layer(p, 2, smem); phase_norm(p, 2, 0, MALL); break;
      case 27: convert_layer(p, 3, smem); phase_norm(p, 3, 0, MALL); break;
      case 8: phase_norm(p, 0, 1, MALL); break;
      case 16: phase_norm(p, 1, 1, MALL); break;
      case 24: phase_norm(p, 2, 1, MALL); break;
      case 34: phase_norm(p, 3, 1, MALL); break;
      case 3: phase_mla_post1(p); break;
      case 5: phase_mla_post2(p); break;
      case 13: phase_gqa_post(p); break;
      case 21: phase_na_post(p); break;
      case 29: phase_ret_post(p, smem); break;
      case 6:
        attn_phase<192, 128, false, 64>(p, (const u16*)(p.arena + A0_Q), (const u16*)(p.arena + A0_K), (const u16*)(p.arena + A0_VT), (u16*)(p.arena + A0_O), 8, 8,
                                    0.07216878364870322f, nullptr, true, true, smem);
        break;
      case 14:
        attn_phase<128, 128, false, 64>(p, (const u16*)(p.arena + A1_Q), (const u16*)(p.arena + A1_K), (const u16*)(p.arena + A1_VT), (u16*)(p.arena + A1_O), 8, 2,
                                    0.08838834764831845f, nullptr, true, true, smem);
        break;
      case 22:
        attn_phase<64, 64, true, 64>(p, (const u16*)(p.arena + A2_Q), (const u16*)(p.arena + A2_K), (const u16*)(p.arena + A2_VT), (u16*)(p.arena + A2_O), 16, 16,
                                 0.125f, p.in[25], true, false, smem);
        attn_phase<64, 64, false, 64>(p, (const u16*)(p.arena + A2_Q), (const u16*)(p.arena + A2_K), (const u16*)(p.arena + A2_VT), (u16*)(p.arena + A2_O), 16, 16,
                                  0.125f, nullptr, false, true, smem);
        break;
      case 31: phase_ret_scan(p, smem); break;
      case 32: phase_ret_gate(p); break;
      default:
#ifdef DBG_SKIP
        if (ph == DBG_SKIP) break;
#endif
        gemm_phase(p, ph, smem); break;
    }
#ifdef REPEAT_PH
    if (ph == REPEAT_PH && !rep) { rep = 1; xcd_barrier(xb); --ph; continue; }
    rep = 0;
#endif
    if (ph + 1 < ph_hi) { if (ph_lo < 0) grid.sync(); else xcd_barrier(xb); }
  }
}

extern "C" void kernel_launch(void* const* d_in, const int* in_sizes, int n_in, void* d_out, int out_size, void* d_ws, size_t ws_size,
                              hipStream_t stream) {
  static int grid_blocks = 0;
  if (!grid_blocks) {
    int dev = 0, cus = 0, per_cu = 0;
    hipGetDevice(&dev);
    hipDeviceGetAttribute(&cus, hipDeviceAttributeMultiprocessorCount, dev);
    hipOccupancyMaxActiveBlocksPerMultiprocessor(&per_cu, fwd_megakernel, 256, 0);
    if (per_cu > 2) per_cu = 2;
    grid_blocks = cus * per_cu;
  }
  Params p{};
  for (int i = 0; i < 32; ++i) p.in[i] = (const float*)d_in[i];
  p.out = (float*)d_out;
  char* ws = (char*)d_ws;
  size_t off = 0;
  p.modv = (float*)(ws + off); off += 4 * 3 * 6144 * 4;
  p.tab = (float2*)(ws + off); off += 128 * 112 * 8;
  p.hctx = (float*)(ws + off); off += (size_t)512 * 1024 * 4;
  p.wt = (u16*)(ws + off); off += WT_ELEMS * 2;
  p.xn = (u16*)(ws + off); off += (size_t)MALL * 1024 * 2;
  p.arena = ws + off; off += ARENA_BYTES;
  p.bar = (unsigned*)(ws + off); off += XCD_BAR_WORDS * 4;
  if (off > ws_size) { fprintf(stderr, "workspace too small: need %zu have %zu\n", off, ws_size); return; }
  p.phase_lo = 0; p.phase_hi = NPHASE;
  (void)hipMemsetAsync(p.bar, 0, XCD_BAR_WORDS * 4, stream);
  void* args[] = {&p};
  hipError_t e = hipLaunchCooperativeKernel((void*)fwd_megakernel, dim3(grid_blocks), dim3(256), args, 0, stream);
  if (e != hipSuccess) fprintf(stderr, "cooperative launch failed: %s (grid %d)\n", hipGetErrorString(e), grid_blocks);
}
```

```cpp
#define BIGBK 64
#define BIGDIST 2
#include <hip/hip_runtime.h>
#include <hip/hip_cooperative_groups.h>
#include <cstdio>
namespace cg = cooperative_groups;

#define DI __device__ __forceinline__
typedef unsigned short u16;
typedef __attribute__((ext_vector_type(8))) short bf16x8;
typedef __attribute__((ext_vector_type(4))) short bf16x4;
typedef __attribute__((ext_vector_type(4))) float f32x4;
typedef __attribute__((ext_vector_type(16))) float f32x16;
typedef __attribute__((ext_vector_type(2))) float f32x2;
typedef __attribute__((ext_vector_type(4))) unsigned u32x4;
typedef __attribute__((ext_vector_type(2))) unsigned u32x2;
typedef __attribute__((ext_vector_type(2))) __bf16 bfv2;

constexpr int D = 1024, ML = 16384, MALL = 16896, TEXT = 8448, FH = 2816;
constexpr float LOG2E = 1.4426950408889634f;
constexpr float EPS = 1e-6f;
constexpr size_t W13T = 0, W2T = 5767168, MIX = 8650752;
constexpr size_t WT_ELEMS = MIX + 8388608;
constexpr int NPHASE = 37;
#ifndef BIGBK
#define BIGBK 32
#define BIGDIST 3
#endif

struct Params {
  const float* in[32];
  float* out;
  float* modv;
  float2* tab;
  float* hctx;
  u16* wt;
  u16* xn;
  char* arena;
  unsigned* bar;
  int phase_lo, phase_hi;
};

#define PRM const __attribute__((address_space(4))) Params&
DI int get_tid() { int t = threadIdx.x; asm volatile("" : "+v"(t)); return t; }
DI int get_bid() { int b = blockIdx.x; asm volatile("" : "+s"(b)); return b; }
DI u16 f2bf(float x) { __bf16 b = (__bf16)x; return __builtin_bit_cast(u16, b); }
DI float bf2f(u16 v) { return __uint_as_float(((unsigned)v) << 16); }
DI unsigned pack2(float a, float b) { f32x2 f = {a, b}; bfv2 r = __builtin_convertvector(f, bfv2); return __builtin_bit_cast(unsigned, r); }
DI float wave_sum(float v) { for (int o = 32; o > 0; o >>= 1) v += __shfl_xor(v, o); return v; }
DI float silu(float x) { return x / (1.f + __expf(-x)); }
DI float ex2(float x) { return __builtin_amdgcn_exp2f(x); }
DI int clampi(int x, int lo, int hi) { return x < lo ? lo : (x > hi ? hi : x); }
DI int mod_idx(int m) { return m < 8192 ? 0 : (m < ML ? 1 : 2); }
DI void tok_bt(int m, int& b, int& t) { if (m < ML) { b = m >> 13; t = 256 + (m & 8191); } else { int c = m - ML; b = c >> 8; t = c & 255; } }
DI float* hrow(PRM p, int m) { return m < ML ? p.out + (size_t)m * D : p.hctx + (size_t)(m - ML) * D; }
#define MFMA16(a, b, c) __builtin_amdgcn_mfma_f32_16x16x32_bf16((a), (b), (c), 0, 0, 0)
#define MFMA32(a, b, c) __builtin_amdgcn_mfma_f32_32x32x16_bf16((a), (b), (c), 0, 0, 0)

DI int map_row(int mode, int n) {
  if (mode == 1) return n < FH ? 2 * n : 2 * (n - FH) + 1;
  if (mode == 2) { int h = n >> 8, c = n & 255; return c < 128 ? h * 128 + c : 1024 + h * 128 + (c - 128); }
  return n;
}
DI void convert_job(const float* src, int K, int N, int Npad, u16* dst, int mode, char* smem) {
  float* sT = (float*)smem;
  const int tid = get_tid();
  const int nkt = K >> 6, ntot = nkt * (Npad >> 6);
  for (int tile = get_bid(); tile < ntot; tile += gridDim.x) {
    const int k0 = (tile % nkt) * 64, n0 = (tile / nkt) * 64;
    __syncthreads();
#pragma unroll
    for (int i = 0; i < 4; ++i) {
      int r = (tid >> 4) + 16 * i, c4 = (tid & 15) * 4;
      float4 v = make_float4(0.f, 0.f, 0.f, 0.f);
      if (n0 + c4 < N) v = *(const float4*)(src + (size_t)(k0 + r) * N + n0 + c4);
      sT[r * 65 + c4] = v.x; sT[r * 65 + c4 + 1] = v.y; sT[r * 65 + c4 + 2] = v.z; sT[r * 65 + c4 + 3] = v.w;
    }
    __syncthreads();
#pragma unroll
    for (int i = 0; i < 2; ++i) {
      int c = tid + 256 * i, n = c >> 3, kc = c & 7;
      float f[8];
#pragma unroll
      for (int j = 0; j < 8; ++j) f[j] = sT[(kc * 8 + j) * 65 + n];
      uint4 pk = make_uint4(pack2(f[0], f[1]), pack2(f[2], f[3]), pack2(f[4], f[5]), pack2(f[6], f[7]));
      int nn = n0 + n;
      int row = nn < N ? map_row(mode, nn) : nn;
      *(uint4*)(dst + (size_t)row * K + k0 + kc * 8) = pk;
    }
  }
  __syncthreads();
}
DI void convert_layer(PRM p, int l, char* smem) {
  convert_job(p.in[8] + (size_t)l * 1024 * 5632, 1024, 5632, 5632, p.wt + W13T, 1, smem);
  convert_job(p.in[9] + (size_t)l * 2816 * 1024, 2816, 1024, 1024, p.wt + W2T, 0, smem);
  if (l == 0) {
    convert_job(p.in[10], 1024, 704, 768, p.wt + MIX, 0, smem);
    convert_job(p.in[13], 384, 1536, 1536, p.wt + MIX + 786432, 0, smem);
    convert_job(p.in[14], 256, 2048, 2048, p.wt + MIX + 786432 + 589824, 2, smem);
    convert_job(p.in[17], 1024, 1024, 1024, p.wt + MIX + 786432 + 589824 + 524288, 0, smem);
  } else if (l == 1) {
    convert_job(p.in[18], 1024, 1536, 1536, p.wt + MIX, 0, smem);
    convert_job(p.in[21], 1024, 1024, 1024, p.wt + MIX + 1572864, 0, smem);
  } else if (l == 2) {
    convert_job(p.in[22], 1024, 3072, 3072, p.wt + MIX, 0, smem);
    convert_job(p.in[26], 1024, 1024, 1024, p.wt + MIX + 3145728, 0, smem);
  } else {
    convert_job(p.in[27], 1024, 6144, 6144, p.wt + MIX, 0, smem);
    convert_job(p.in[31], 2048, 1024, 1024, p.wt + MIX + 6291456, 0, smem);
  }
}

DI void phase_init(PRM p, char* smem) {
  const int tid = get_tid(), lane = tid & 63, wave = tid >> 6;
  const size_t gtid = (size_t)get_bid() * 256 + tid, gstr = (size_t)gridDim.x * 256;
  {
    const float4* s2 = (const float4*)p.in[2]; float4* d2 = (float4*)p.hctx;
    for (size_t i = gtid; i < (size_t)512 * D / 4; i += gstr) d2[i] = s2[i];
  }
  for (size_t idx = gtid; idx < 128 * 112; idx += gstr) {
    int Qt, loc;
    if (idx < 2048) { Qt = 16; loc = (int)idx; } else if (idx < 6144) { Qt = 32; loc = (int)idx - 2048; } else { Qt = 64; loc = (int)idx - 6144; }
    int pos = loc / Qt, j = loc % Qt;
    float inv = exp2f(-(float)j / (float)Qt * 13.287712379549449f);
    float ang = (float)pos * inv;
    p.tab[idx] = make_float2(cosf(ang), sinf(ang));
  }
  {
    float* sc = (float*)smem;
    float* red = sc + 3 * 1024;
    if (get_bid() < 384) {
      for (int i = tid; i < 3072; i += 256) {
        int v = i >> 10, k = i & 1023;
        float x = v < 2 ? p.in[1][v * 1024 + k] : p.in[3][k];
        sc[i] = silu(x);
      }
    }
    __syncthreads();
    for (int cb = get_bid(); cb < 384; cb += gridDim.x) {
      int l = cb / 96, n = (cb % 96) * 64 + lane;
      const float* w = p.in[4] + (size_t)l * 1024 * 6144 + n;
      float a0 = 0.f, a1 = 0.f, a2 = 0.f;
      int kb = wave * 256;
#pragma unroll 8
      for (int k = 0; k < 256; ++k) {
        float wv = w[(size_t)(kb + k) * 6144];
        a0 += sc[kb + k] * wv; a1 += sc[1024 + kb + k] * wv; a2 += sc[2048 + kb + k] * wv;
      }
      red[(wave * 3 + 0) * 64 + lane] = a0; red[(wave * 3 + 1) * 64 + lane] = a1; red[(wave * 3 + 2) * 64 + lane] = a2;
      __syncthreads();
      if (tid < 192) {
        int v = tid >> 6;
        float s = red[(0 * 3 + v) * 64 + lane] + red[(1 * 3 + v) * 64 + lane] + red[(2 * 3 + v) * 64 + lane] + red[(3 * 3 + v) * 64 + lane];
        p.modv[(size_t)(l * 3 + v) * 6144 + n] = s + p.in[5][l * 6144 + n];
      }
      __syncthreads();
    }
  }
  convert_layer(p, 0, smem);
}

DI void phase_norm(PRM p, int l, int which, int Mrows) {
  const int lane = get_tid() & 63, wave = get_tid() >> 6;
  const float* gain = p.in[which ? 7 : 6] + l * D;
  const int sc_off = which ? 4 * D : D, sh_off = which ? 3 * D : 0;
  const int stride = gridDim.x * 4;
  for (int m0 = get_bid() * 4 + wave; m0 < Mrows; m0 += 4 * stride) {
    float4 v[4][4]; float ss[4];
#pragma unroll
    for (int k = 0; k < 4; ++k) {
      const int m = m0 + k * stride;
      ss[k] = 0.f;
      if (m < Mrows) {
        const float* h = (l == 0 && which == 0 && m < ML) ? p.in[0] + (size_t)m * D : hrow(p, m);
#pragma unroll
        for (int i = 0; i < 4; ++i) v[k][i] = *(const float4*)(h + i * 256 + lane * 4);
      } else {
#pragma unroll
        for (int i = 0; i < 4; ++i) v[k][i] = make_float4(0.f, 0.f, 0.f, 0.f);
      }
    }
#pragma unroll
    for (int k = 0; k < 4; ++k) {
#pragma unroll
      for (int i = 0; i < 4; ++i) ss[k] += v[k][i].x * v[k][i].x + v[k][i].y * v[k][i].y + v[k][i].z * v[k][i].z + v[k][i].w * v[k][i].w;
      ss[k] = wave_sum(ss[k]);
    }
#pragma unroll
    for (int k = 0; k < 4; ++k) {
      const int m = m0 + k * stride;
      if (m < Mrows) {
        const float* mv = p.modv + (size_t)(l * 3 + mod_idx(m)) * 6144;
        const float r = rsqrtf(ss[k] * (1.f / 1024.f) + EPS);
#pragma unroll
        for (int i = 0; i < 4; ++i) {
          int c = i * 256 + lane * 4;
          float4 g = *(const float4*)(gain + c), sc = *(const float4*)(mv + sc_off + c), sh = *(const float4*)(mv + sh_off + c);
          float y0 = v[k][i].x * r * g.x * (1.f + sc.x) + sh.x, y1 = v[k][i].y * r * g.y * (1.f + sc.y) + sh.y;
          float y2 = v[k][i].z * r * g.z * (1.f + sc.z) + sh.z, y3 = v[k][i].w * r * g.w * (1.f + sc.w) + sh.w;
          *(uint2*)(p.xn + (size_t)m * D + c) = make_uint2(pack2(y0, y1), pack2(y2, y3));
        }
      }
    }
  }
}

enum { EPI_STORE = 0, EPI_VT = 1, EPI_RESID = 2, EPI_SWIGLU = 3, EPI_RETP = 4 };
struct GJob { const u16* P; const u16* Q; int ldp, ldq, K, nI, nJ, epi; u16* o; int ld, a, b; };

DI GJob mkjob(const u16* P, int ldp, const u16* Q, int ldq, int K, int nI, int nJ, int epi, u16* o, int ld, int a, int b) {
  GJob J; J.P = P; J.Q = Q; J.ldp = ldp; J.ldq = ldq; J.K = K; J.nI = nI; J.nJ = nJ; J.epi = epi; J.o = o; J.ld = ld; J.a = a; J.b = b; return J;
}
constexpr size_t A0_RAW1 = 0, A0_CQN = 25952256, A0_CKVN = A0_CQN + 12976128, A0_QRAW = A0_CKVN + 8650752, A0_KNRAW = A0_QRAW + 51904512,
                 A0_Q = A0_KNRAW + 34603008, A0_K = A0_Q + 51904512, A0_VT = A0_K + 51904512, A0_O = A0_QRAW;
constexpr size_t A1_RAW = 0, A1_Q = 43253760, A1_K = A1_Q + 34603008, A1_VT = A1_K + 8650752, A1_O = A1_VT + 8650752;
constexpr size_t A2_RAW = 0, A2_Q = 69206016, A2_K = A2_Q + 34603008, A2_VT = A2_K + 34603008, A2_O = A2_VT + 34603008;
constexpr size_t A3_RAW = 0, A3_Y = 0, A3_VT = 69206016, A3_U = A3_VT, A3_G = A3_VT + 69206016, A3_KN = A3_G + 67108864, A3_KT = A3_KN + 33554432,
                 A3_P = A3_KT + 34603008, A3_END = A3_P + 33554432;
constexpr size_t ARENA_BYTES = A3_END;

DI GJob make_job(PRM p, int ph, int jj) {
  u16* ar = (u16*)p.arena;
  const u16* wt = p.wt;
  GJob Z = mkjob(nullptr, 0, nullptr, 0, 0, 0, 0, 0, nullptr, 0, 0, 0);
  switch (ph) {
    case 2: if (jj == 0) return mkjob(wt + MIX, 1024, p.xn, 1024, 1024, 3, 132, EPI_STORE, (u16*)(p.arena + A0_RAW1), 768, 768, 0); break;
    case 4:
      if (jj == 0) return mkjob(wt + MIX + 786432, 384, (u16*)(p.arena + A0_CQN), 384, 384, 6, 132, EPI_STORE, (u16*)(p.arena + A0_QRAW), 1536, 1536, 0);
      if (jj == 1) return mkjob(wt + MIX + 786432 + 589824, 256, (u16*)(p.arena + A0_CKVN), 256, 256, 4, 132, EPI_STORE, (u16*)(p.arena + A0_KNRAW), 1024, 1024, 0);
      if (jj == 2) return mkjob((u16*)(p.arena + A0_CKVN), 256, wt + MIX + 786432 + 589824 + 1024 * 256, 256, 256, 66, 8, EPI_VT, (u16*)(p.arena + A0_VT), 0, 7, 8);
      break;
    case 7: if (jj == 0) return mkjob(wt + MIX + 786432 + 589824 + 524288, 1024, (u16*)(p.arena + A0_O), 1024, 1024, 8, 176, EPI_RESID, nullptr, 0, 0, 2 * D); break;
    case 12:
      if (jj == 0) return mkjob(wt + MIX, 1024, p.xn, 1024, 1024, 5, 132, EPI_STORE, (u16*)(p.arena + A1_RAW), 1280, 1280, 0);
      if (jj == 1) return mkjob(p.xn, 1024, wt + MIX + 1280 * 1024, 1024, 1024, 66, 2, EPI_VT, (u16*)(p.arena + A1_VT), 0, 7, 2);
      break;
    case 15: if (jj == 0) return mkjob(wt + MIX + 1572864, 1024, (u16*)(p.arena + A1_O), 1024, 1024, 8, 176, EPI_RESID, nullptr, 0, 1, 2 * D); break;
    case 20:
      if (jj == 0) return mkjob(wt + MIX, 1024, p.xn, 1024, 1024, 8, 132, EPI_STORE, (u16*)(p.arena + A2_RAW), 2048, 2048, 0);
      if (jj == 1) return mkjob(p.xn, 1024, wt + MIX + 2048 * 1024, 1024, 1024, 66, 8, EPI_VT, (u16*)(p.arena + A2_VT), 0, 6, 16);
      break;
    case 23: if (jj == 0) return mkjob(wt + MIX + 3145728, 1024, (u16*)(p.arena + A2_O), 1024, 1024, 8, 176, EPI_RESID, nullptr, 0, 2, 2 * D); break;
    case 28:
      if (jj == 0) return mkjob(wt + MIX, 1024, p.xn, 1024, 1024, 8, 132, EPI_STORE, (u16*)(p.arena + A3_RAW), 2048, 2048, 0);
      if (jj == 1) return mkjob(p.xn, 1024, wt + MIX + 2048 * 1024, 1024, 1024, 66, 16, EPI_VT, (u16*)(p.arena + A3_VT), 0, 9, 4);
      if (jj == 2) return mkjob(wt + MIX + 4096 * 1024, 1024, p.xn, 1024, 1024, 8, 128, EPI_STORE, (u16*)(p.arena + A3_G), 2048, 2048, 0);
      break;
    case 30: if (jj == 0) return mkjob((u16*)(p.arena + A3_KN), 1024, p.xn, 1024, 256, 512, 1, EPI_RETP, (u16*)(p.arena + A3_P), 0, 0, 0); break;
    case 33: if (jj == 0) return mkjob(wt + MIX + 6291456, 2048, (u16*)(p.arena + A3_U), 2048, 2048, 8, 176, EPI_RESID, nullptr, 0, 3, 2 * D); break;
    case 9: case 17: case 25: case 35:
      if (jj == 0) return mkjob(wt + W13T, 1024, p.xn, 1024, 1024, 22, 132, EPI_SWIGLU, ar, 0, 0, 0);
      break;
    case 10: case 18: case 26: case 36:
      if (jj == 0) return mkjob(wt + W2T, 2816, ar, 2816, 2816, 8, 176, EPI_RESID, nullptr, 0, (ph - 10) / 8 + (ph == 36 ? 0 : 0), 5 * D);
      break;
    default: break;
  }
  return Z;
}

template <int MT, int NT, int BK, int DIST>
DI void gemm_core(PRM p, const GJob& J, const u16* Pb, const u16* Qb, int i0, int j0, int aux, char* smem) {
  constexpr int LS = BK + 16, CPR = BK / 8;
  constexpr int RPI = 256 / CPR, NP = MT * 32 / RPI, NQ = NT * 32 / RPI, KS = BK / 32;
  const int tid = get_tid(), lane = tid & 63, wave = tid >> 6, wi = wave >> 1, wj = wave & 1, fr = lane & 15, fq = lane >> 4;
  u16* sP = (u16*)smem; u16* sQ = sP + MT * 32 * LS;
  f32x4 acc[MT][NT];
#pragma unroll
  for (int a = 0; a < MT; ++a)
#pragma unroll
    for (int b = 0; b < NT; ++b) acc[a][b] = (f32x4){0.f, 0.f, 0.f, 0.f};
  const u16* gpb = Pb + (size_t)i0 * J.ldp;
  const u16* gqb = Qb + (size_t)j0 * J.ldq;
  const unsigned po = (tid / CPR) * J.ldp + (tid % CPR) * 8, qo = (tid / CPR) * J.ldq + (tid % CPR) * 8;
  const unsigned spr = RPI * J.ldp, sqr = RPI * J.ldq;
  u32x4 rp[NP], rq[NQ];
#pragma unroll
  for (int i = 0; i < NP; ++i) rp[i] = *(const u32x4*)(gpb + (po + spr * i));
#pragma unroll
  for (int i = 0; i < NQ; ++i) rq[i] = *(const u32x4*)(gqb + (qo + sqr * i));
  const int nk = J.K / BK;
  const int so = (tid / CPR) * LS + (tid % CPR) * 8;
  for (int kt = 0; kt < nk; ++kt) {
    __syncthreads();
#pragma unroll
    for (int i = 0; i < NP; ++i) *(u32x4*)(sP + so + RPI * LS * i) = rp[i];
#pragma unroll
    for (int i = 0; i < NQ; ++i) *(u32x4*)(sQ + so + RPI * LS * i) = rq[i];
    __syncthreads();
    if (kt + 1 < nk) {
#pragma unroll
      for (int i = 0; i < NP; ++i) rp[i] = *(const u32x4*)(gpb + (po + spr * i + (kt + 1) * BK));
#pragma unroll
      for (int i = 0; i < NQ; ++i) rq[i] = *(const u32x4*)(gqb + (qo + sqr * i + (kt + 1) * BK));
    }
#pragma unroll
    for (int ks = 0; ks < KS; ++ks) {
      bf16x8 b[NT], a[MT];
#pragma unroll
      for (int nj = 0; nj < NT; ++nj) b[nj] = *(const bf16x8*)(sQ + (wj * NT * 16 + nj * 16 + fr) * LS + ks * 32 + fq * 8);
#define LDA(m) (*(const bf16x8*)(sP + (wi * MT * 16 + (m) * 16 + fr) * LS + ks * 32 + fq * 8))
#pragma unroll
      for (int m = 0; m < DIST; ++m) a[m] = LDA(m);
      __builtin_amdgcn_sched_barrier(0);
#pragma unroll
      for (int mi = 0; mi < MT; ++mi) {
        if (mi + DIST < MT) a[mi + DIST] = LDA(mi + DIST);
#pragma unroll
        for (int nj = 0; nj < NT; ++nj) acc[mi][nj] = MFMA16(a[mi], b[nj], acc[mi][nj]);
        __builtin_amdgcn_sched_barrier(0);
      }
#undef LDA
    }
  }
  if (MT == 8 && J.epi == EPI_SWIGLU) {
    u16* sO = (u16*)smem;
    __syncthreads();
#pragma unroll
    for (int mi = 0; mi < MT; ++mi)
#pragma unroll
      for (int nj = 0; nj < NT; ++nj) {
        const int ul = (wi * MT * 16 + mi * 16 + fq * 4) >> 1, jl = wj * NT * 16 + nj * 16 + fr;
        const f32x4 v = acc[mi][nj];
        *(unsigned*)(sO + jl * 136 + ul) = pack2(silu(v[0]) * v[1], silu(v[2]) * v[3]);
      }
    __syncthreads();
    const int row = tid >> 1, half = tid & 1;
    u16* dst = J.o + (size_t)(j0 + row) * FH + (i0 >> 1) + half * 64;
#pragma unroll
    for (int c = 0; c < 8; ++c) *(u32x4*)(dst + c * 8) = *(const u32x4*)(sO + row * 136 + half * 64 + c * 8);
    return;
  }
  if (NT == 3 && J.epi == EPI_RESID) {
    float* sO = (float*)smem;
    __syncthreads();
#pragma unroll
    for (int mi = 0; mi < MT; ++mi)
#pragma unroll
      for (int nj = 0; nj < NT; ++nj) {
        const int il = wi * MT * 16 + mi * 16 + fq * 4, jl = wj * NT * 16 + nj * 16 + fr;
        *(f32x4*)(sO + jl * 132 + il) = acc[mi][nj];
      }
    __syncthreads();
#pragma unroll
    for (int k = 0; k < 12; ++k) {
      const int c = tid + 256 * k, row = c >> 5, ch = c & 31, j = j0 + row, i = i0 + ch * 4;
      const f32x4 v = *(const f32x4*)(sO + row * 132 + ch * 4);
      float* hp = hrow(p, j) + i;
      const float* hin = (J.a == 0 && J.b == 2 * D && j < ML) ? p.in[0] + (size_t)j * D + i : hp;
      const float4 g = *(const float4*)(p.modv + (size_t)(J.a * 3 + mod_idx(j)) * 6144 + J.b + i);
      float4 hv = *(const float4*)hin;
      hv.x += g.x * v[0]; hv.y += g.y * v[1]; hv.z += g.z * v[2]; hv.w += g.w * v[3];
      *(float4*)hp = hv;
    }
    return;
  }
  float ldf2 = 0.f, ldb2 = 0.f;
  if (J.epi == EPI_RETP) { int h = (aux >> 6) & 3; ldf2 = p.in[28][h] * LOG2E; ldb2 = p.in[29][h] * LOG2E; }
#pragma unroll
  for (int mi = 0; mi < MT; ++mi)
#pragma unroll
    for (int nj = 0; nj < NT; ++nj) {
      const int i = i0 + wi * MT * 16 + mi * 16 + fq * 4, j = j0 + wj * NT * 16 + nj * 16 + fr;
      const f32x4 v = acc[mi][nj];
      if (J.epi == EPI_STORE) {
        if (i < J.a) *(uint2*)(J.o + (size_t)j * J.ld + i) = make_uint2(pack2(v[0], v[1]), pack2(v[2], v[3]));
      } else if (J.epi == EPI_VT) {
        int b, t; tok_bt(i, b, t);
        int hh = j >> J.a, dv = j & ((1 << J.a) - 1);
        *(uint2*)(J.o + ((size_t)((b * J.b + hh) << J.a) + dv) * TEXT + t) = make_uint2(pack2(v[0], v[1]), pack2(v[2], v[3]));
      } else if (J.epi == EPI_RESID) {
        float* hp = hrow(p, j) + i;
        const float4 g = *(const float4*)(p.modv + (size_t)(J.a * 3 + mod_idx(j)) * 6144 + J.b + i);
        float4 hv = *(float4*)hp;
        hv.x += g.x * v[0]; hv.y += g.y * v[1]; hv.z += g.z * v[2]; hv.w += g.w * v[3];
        *(float4*)hp = hv;
      } else if (J.epi == EPI_SWIGLU) {
        *(unsigned*)(J.o + (size_t)j * FH + (i >> 1)) = pack2(silu(v[0]) * v[1], silu(v[2]) * v[3]);
      } else {
        float pf[4], pb[4];
#pragma unroll
        for (int r = 0; r < 4; ++r) {
          int t = i + r, d = j - t;
          pf[r] = d >= 0 ? v[r] * ex2((float)d * ldf2) : 0.f;
          pb[r] = d <= 0 ? v[r] * ex2((float)(-d) * ldb2) : 0.f;
        }
        size_t off = ((size_t)aux * 128 + j) * 128 + i;
        *(uint2*)(J.o + off) = make_uint2(pack2(pf[0], pf[1]), pack2(pf[2], pf[3]));
        *(uint2*)(J.o + (size_t)512 * 128 * 128 + off) = make_uint2(pack2(pb[0], pb[1]), pack2(pb[2], pb[3]));
      }
    }
}

DI void gemm_phase(PRM p, int ph, char* smem) {
  int total = 0;
  for (int jj = 0; jj < 3; ++jj) { GJob J = make_job(p, ph, jj); total += J.nI * J.nJ; }
  const int G = gridDim.x, G8 = G >> 3, bid = get_bid();
  const int nround = (total + G - 1) / G;
  for (int r = 0; r < nround; ++r) {
    const int L = (r * 8 + (bid & 7)) * G8 + (bid >> 3);
    if (L >= total) continue;
    int t = L, jj = 0;
    GJob J = make_job(p, ph, 0);
    while (t >= J.nI * J.nJ) { t -= J.nI * J.nJ; ++jj; J = make_job(p, ph, jj); }
    if (J.epi == EPI_RETP) {
      int bh = t >> 6, chunk = t & 63, b = bh >> 2, h = bh & 3;
      size_t off = (size_t)(b * 8192 + chunk * 128) * 1024 + h * 256;
      gemm_core<4, 4, 64, 2>(p, J, J.P + off, J.Q + off, 0, 0, t, smem);
    } else {
      const int band = t / (8 * J.nI), rr = t % (8 * J.nI);
      const int hgt = min(8, J.nJ - band * 8);
      const int ti = rr / hgt, tj = band * 8 + rr % hgt;
      if (J.epi == EPI_RESID) gemm_core<4, 3, 64, 2>(p, J, J.P, J.Q, ti * 128, tj * 96, 0, smem);
      else gemm_core<8, 4, BIGBK, BIGDIST>(p, J, J.P, J.Q, ti * 256, tj * 128, 0, smem);
    }
  }
}

DI void phase_mla_post1(PRM p) {
  const int lane = get_tid() & 63, wave = get_tid() >> 6;
  const u16* raw = (const u16*)(p.arena + A0_RAW1);
  u16* cqn = (u16*)(p.arena + A0_CQN); u16* ckvn = (u16*)(p.arena + A0_CKVN);
  for (int m = get_bid() * 4 + wave; m < MALL; m += gridDim.x * 4) {
    const u16* r = raw + (size_t)m * 768;
    float q[6], k[4], sq = 0.f, sk = 0.f;
#pragma unroll
    for (int i = 0; i < 6; ++i) { q[i] = bf2f(r[lane + 64 * i]); sq += q[i] * q[i]; }
#pragma unroll
    for (int i = 0; i < 4; ++i) { k[i] = bf2f(r[384 + lane + 64 * i]); sk += k[i] * k[i]; }
    sq = wave_sum(sq); sk = wave_sum(sk);
    float rq = rsqrtf(sq * (1.f / 384.f) + EPS), rk = rsqrtf(sk * (1.f / 256.f) + EPS);
#pragma unroll
    for (int i = 0; i < 6; ++i) cqn[(size_t)m * 384 + lane + 64 * i] = f2bf(q[i] * rq * p.in[11][lane + 64 * i]);
#pragma unroll
    for (int i = 0; i < 4; ++i) ckvn[(size_t)m * 256 + lane + 64 * i] = f2bf(k[i] * rk * p.in[12][lane + 64 * i]);
  }
}
DI void phase_mla_post2(PRM p) {
  const int lane = get_tid() & 63, wave = get_tid() >> 6;
  const u16* raw1 = (const u16*)(p.arena + A0_RAW1);
  const u16* qraw = (const u16*)(p.arena + A0_QRAW);
  const u16* knraw = (const u16*)(p.arena + A0_KNRAW);
  u16* Qf = (u16*)(p.arena + A0_Q); u16* Kf = (u16*)(p.arena + A0_K);
  const int nitems = MALL * 16, stride = gridDim.x * 4;
  const float gq0 = p.in[15][lane], gq1 = p.in[15][lane + 64], gq2 = p.in[15][lane + 128];
  const float gk0 = p.in[16][lane], gk1 = p.in[16][lane + 64], gk2 = p.in[16][lane + 128];
  for (int it0 = get_bid() * 4 + wave; it0 < nitems; it0 += 4 * stride) {
    u16 rv[4][3];
#pragma unroll
    for (int u = 0; u < 4; ++u) {
      const int it = it0 + u * stride;
      rv[u][0] = rv[u][1] = rv[u][2] = 0;
      if (it < nitems) {
        const int m = it >> 4, hh = it & 15, isk = hh >> 3, h = hh & 7;
        if (!isk) {
          const u16* s = qraw + (size_t)m * 1536 + h * 192;
          rv[u][0] = s[lane]; rv[u][1] = s[lane + 64]; rv[u][2] = s[lane + 128];
        } else {
          const u16* s = knraw + (size_t)m * 1024 + h * 128;
          rv[u][0] = s[lane]; rv[u][1] = s[lane + 64]; rv[u][2] = raw1[(size_t)m * 768 + 640 + lane];
        }
      }
    }
#pragma unroll
    for (int u = 0; u < 4; ++u) {
      const int it = it0 + u * stride;
      if (it < nitems) {
        const int m = it >> 4, hh = it & 15, isk = hh >> 3, h = hh & 7;
        float v0 = bf2f(rv[u][0]), v1 = bf2f(rv[u][1]), v2 = bf2f(rv[u][2]);
        float ss = wave_sum(v0 * v0 + v1 * v1 + v2 * v2);
        float r = rsqrtf(ss * (1.f / 192.f) + EPS);
        v0 *= r * (isk ? gk0 : gq0); v1 *= r * (isk ? gk1 : gq1); v2 *= r * (isk ? gk2 : gq2);
        float partner = __shfl_xor(v2, 32);
        if (m < ML) {
          int sq = m & 8191, pr = lane & 31;
          int pos = pr < 16 ? (sq >> 6) : (sq & 63);
          float2 cs = p.tab[pos * 16 + (pr & 15)];
          v2 = lane < 32 ? v2 * cs.x - partner * cs.y : partner * cs.y + v2 * cs.x;
        }
        u16* d;
        if (!isk) d = Qf + (size_t)m * 1536 + h * 192;
        else { int b, t; tok_bt(m, b, t); d = Kf + ((size_t)(b * 8 + h) * TEXT + t) * 192; }
        d[lane] = f2bf(v0); d[lane + 64] = f2bf(v1); d[lane + 128] = f2bf(v2);
      }
    }
  }
}
DI void phase_gqa_post(PRM p) {
  const int lane = get_tid() & 63, wave = get_tid() >> 6;
  const u16* raw = (const u16*)(p.arena + A1_RAW);
  u16* Qf = (u16*)(p.arena + A1_Q); u16* Kf = (u16*)(p.arena + A1_K);
  const int nitems = MALL * 10, stride = gridDim.x * 4;
  const float gq0 = p.in[19][lane], gq1 = p.in[19][lane + 64], gk0 = p.in[20][lane], gk1 = p.in[20][lane + 64];
  for (int it0 = get_bid() * 4 + wave; it0 < nitems; it0 += 4 * stride) {
    u16 rv[4][2];
#pragma unroll
    for (int u = 0; u < 4; ++u) {
      const int it = it0 + u * stride;
      rv[u][0] = rv[u][1] = 0;
      if (it < nitems) {
        const int m = it / 10, hh = it % 10;
        const u16* s = raw + (size_t)m * 1280 + hh * 128;
        rv[u][0] = s[lane]; rv[u][1] = s[lane + 64];
      }
    }
#pragma unroll
    for (int u = 0; u < 4; ++u) {
      const int it = it0 + u * stride;
      if (it < nitems) {
        const int m = it / 10, hh = it % 10, isk = hh >= 8;
        float x1 = bf2f(rv[u][0]), x2 = bf2f(rv[u][1]);
        float ss = wave_sum(x1 * x1 + x2 * x2);
        float r = rsqrtf(ss * (1.f / 128.f) + EPS);
        x1 *= r * (isk ? gk0 : gq0); x2 *= r * (isk ? gk1 : gq1);
        if (m < ML) {
          int sq = m & 8191;
          int pos = lane < 32 ? (sq >> 6) : (sq & 63);
          float2 cs = p.tab[2048 + pos * 32 + (lane & 31)];
          float y1 = x1 * cs.x - x2 * cs.y, y2 = x1 * cs.y + x2 * cs.x;
          x1 = y1; x2 = y2;
        }
        u16* d;
        if (!isk) d = Qf + (size_t)m * 1024 + hh * 128;
        else { int b, t; tok_bt(m, b, t); d = Kf + ((size_t)(b * 2 + (hh - 8)) * TEXT + t) * 128; }
        d[lane] = f2bf(x1); d[lane + 64] = f2bf(x2);
      }
    }
  }
}
DI void phase_na_post(PRM p) {
  const int lane = get_tid() & 63, wave = get_tid() >> 6;
  const u16* raw = (const u16*)(p.arena + A2_RAW);
  u16* Qf = (u16*)(p.arena + A2_Q); u16* Kf = (u16*)(p.arena + A2_K);
  const int stride = gridDim.x * 4;
  float gq[8], gk[8];
#pragma unroll
  for (int j = 0; j < 8; ++j) { gq[j] = p.in[23][(lane & 7) * 8 + j]; gk[j] = p.in[24][(lane & 7) * 8 + j]; }
  for (int m = get_bid() * 4 + wave; m < MALL; m += stride) {
    u32x4 rv[4];
#pragma unroll
    for (int ps = 0; ps < 4; ++ps) rv[ps] = *(const u32x4*)(raw + (size_t)m * 2048 + ps * 512 + lane * 8);
    int b, t; tok_bt(m, b, t);
#pragma unroll
    for (int ps = 0; ps < 4; ++ps) {
      float f[8]; float ss = 0.f;
#pragma unroll
      for (int j = 0; j < 4; ++j) { f[2 * j] = __uint_as_float(rv[ps][j] << 16); f[2 * j + 1] = __uint_as_float(rv[ps][j] & 0xffff0000u); }
#pragma unroll
      for (int j = 0; j < 8; ++j) ss += f[j] * f[j];
      ss += __shfl_xor(ss, 1); ss += __shfl_xor(ss, 2); ss += __shfl_xor(ss, 4);
      const float r = rsqrtf(ss * (1.f / 64.f) + EPS);
      const bool isk = ps >= 2;
      unsigned w[4];
#pragma unroll
      for (int j = 0; j < 4; ++j) w[j] = pack2(f[2 * j] * r * (isk ? gk[2 * j] : gq[2 * j]), f[2 * j + 1] * r * (isk ? gk[2 * j + 1] : gq[2 * j + 1]));
      const int e = (ps & 1) * 512 + lane * 8, h = e >> 6;
      u16* d = isk ? Kf + ((size_t)(b * 16 + h) * TEXT + t) * 64 + (e & 63) : Qf + (size_t)m * 1024 + e;
      *(u32x4*)d = (u32x4){w[0], w[1], w[2], w[3]};
    }
  }
}
DI void phase_ret_post(PRM p, char* smem) {
  const int tid = get_tid(), lane = tid & 63, wave = tid >> 6;
  const u16* raw = (const u16*)(p.arena + A3_RAW);
  u16* Qf = p.xn; u16* Kn = (u16*)(p.arena + A3_KN); u16* KT = (u16*)(p.arena + A3_KT);
  {
    const int stride = gridDim.x * 4, nitems = ML * 4;
    for (int it0 = get_bid() * 4 + wave; it0 < nitems; it0 += 4 * stride) {
      u16 rv[4][4];
#pragma unroll
      for (int k = 0; k < 4; ++k) {
        const int it = it0 + k * stride;
        rv[k][0] = rv[k][1] = rv[k][2] = rv[k][3] = 0;
        if (it < nitems) {
          const u16* s = raw + (size_t)(it >> 2) * 2048 + (it & 3) * 256;
          rv[k][0] = s[lane]; rv[k][1] = s[lane + 64]; rv[k][2] = s[lane + 128]; rv[k][3] = s[lane + 192];
        }
      }
#pragma unroll
      for (int k = 0; k < 4; ++k) {
        const int it = it0 + k * stride;
        if (it < nitems) {
          const int m = it >> 2, h = it & 3, sq = m & 8191;
          float a1 = bf2f(rv[k][0]), b1 = bf2f(rv[k][1]), a2 = bf2f(rv[k][2]), b2 = bf2f(rv[k][3]);
          float2 ca = p.tab[6144 + (sq >> 6) * 64 + lane], cb = p.tab[6144 + (sq & 63) * 64 + lane];
          u16* d = Qf + (size_t)m * 1024 + h * 256;
          d[lane] = f2bf(a1 * ca.x - a2 * ca.y); d[lane + 128] = f2bf(a1 * ca.y + a2 * ca.x);
          d[lane + 64] = f2bf(b1 * cb.x - b2 * cb.y); d[lane + 192] = f2bf(b1 * cb.y + b2 * cb.x);
        }
      }
    }
  }
  u16* sT = (u16*)smem;
  for (int it = get_bid(); it < 264 * 4; it += gridDim.x) {
    const int tb = it >> 2, h = it & 3, m0 = tb * 64;
    __syncthreads();
    for (int t4 = 0; t4 < 16; t4 += 4) {
      u16 rv[4][4];
#pragma unroll
      for (int k = 0; k < 4; ++k) {
        const u16* s = raw + (size_t)(m0 + wave * 16 + t4 + k) * 2048 + 1024 + h * 256;
        rv[k][0] = s[lane]; rv[k][1] = s[lane + 64]; rv[k][2] = s[lane + 128]; rv[k][3] = s[lane + 192];
      }
#pragma unroll
      for (int k = 0; k < 4; ++k) {
        const int tl = wave * 16 + t4 + k, m = m0 + tl;
        float a1 = bf2f(rv[k][0]) * 0.0625f, b1 = bf2f(rv[k][1]) * 0.0625f, a2 = bf2f(rv[k][2]) * 0.0625f, b2 = bf2f(rv[k][3]) * 0.0625f;
        if (m < ML) {
          int sq = m & 8191;
          float2 ca = p.tab[6144 + (sq >> 6) * 64 + lane], cb = p.tab[6144 + (sq & 63) * 64 + lane];
          float y1 = a1 * ca.x - a2 * ca.y, y2 = a1 * ca.y + a2 * ca.x, z1 = b1 * cb.x - b2 * cb.y, z2 = b1 * cb.y + b2 * cb.x;
          a1 = y1; a2 = y2; b1 = z1; b2 = z2;
        }
        u16 o0 = f2bf(a1), o1 = f2bf(b1), o2 = f2bf(a2), o3 = f2bf(b2);
        if (m < ML) { u16* d = Kn + (size_t)m * 1024 + h * 256; d[lane] = o0; d[lane + 64] = o1; d[lane + 128] = o2; d[lane + 192] = o3; }
        u16* r = sT + tl * 258; r[lane] = o0; r[lane + 64] = o1; r[lane + 128] = o2; r[lane + 192] = o3;
      }
    }
    __syncthreads();
    int b, t0; tok_bt(m0, b, t0);
#pragma unroll
    for (int i = 0; i < 8; ++i) {
      int c = tid + 256 * i, k = c & 255, tc = c >> 8;
      u16 e[8];
#pragma unroll
      for (int j = 0; j < 8; ++j) e[j] = sT[(tc * 8 + j) * 258 + k];
      uint4 pk = make_uint4(e[0] | ((unsigned)e[1] << 16), e[2] | ((unsigned)e[3] << 16), e[4] | ((unsigned)e[5] << 16), e[6] | ((unsigned)e[7] << 16));
      *(uint4*)(KT + ((size_t)((b * 4 + h) * 256 + k)) * TEXT + t0 + tc * 8) = pk;
    }
  }
  __syncthreads();
}
DI void phase_ret_gate(PRM p) {
  const int lane = get_tid() & 63, wave = get_tid() >> 6;
  const u16* y = (const u16*)(p.arena + A3_Y); const u16* g = (const u16*)(p.arena + A3_G); u16* u = (u16*)(p.arena + A3_U);
  const int stride = gridDim.x * 4, nitems = ML * 4;
  for (int it0 = get_bid() * 4 + wave; it0 < nitems; it0 += 4 * stride) {
    u32x4 yv[4], gv[4];
#pragma unroll
    for (int k = 0; k < 4; ++k) {
      const int it = it0 + k * stride;
      yv[k] = (u32x4){0u, 0u, 0u, 0u}; gv[k] = yv[k];
      if (it < nitems) {
        const size_t off = (size_t)(it >> 2) * 2048 + (it & 3) * 512 + lane * 8;
        yv[k] = *(const u32x4*)(y + off); gv[k] = *(const u32x4*)(g + off);
      }
    }
#pragma unroll
    for (int k = 0; k < 4; ++k) {
      const int it = it0 + k * stride;
      if (it < nitems) {
        const int h = it & 3;
        const size_t off = (size_t)(it >> 2) * 2048 + h * 512 + lane * 8;
        float f[8], gg[8], s = 0.f;
#pragma unroll
        for (int i = 0; i < 4; ++i) {
          f[2 * i] = __uint_as_float(yv[k][i] << 16); f[2 * i + 1] = __uint_as_float(yv[k][i] & 0xffff0000u);
          gg[2 * i] = __uint_as_float(gv[k][i] << 16); gg[2 * i + 1] = __uint_as_float(gv[k][i] & 0xffff0000u);
        }
#pragma unroll
        for (int i = 0; i < 8; ++i) s += f[i];
        float mu = wave_sum(s) * (1.f / 512.f), vs = 0.f;
#pragma unroll
        for (int i = 0; i < 8; ++i) { f[i] -= mu; vs += f[i] * f[i]; }
        float r = rsqrtf(wave_sum(vs) * (1.f / 512.f) + EPS);
        const float* on = p.in[30] + h * 512 + lane * 8;
        float o[8];
#pragma unroll
        for (int i = 0; i < 8; ++i) o[i] = f[i] * r * on[i] * silu(gg[i]);
        *(u32x4*)(u + off) = (u32x4){pack2(o[0], o[1]), pack2(o[2], o[3]), pack2(o[4], o[5]), pack2(o[6], o[7])};
      }
    }
  }
}

template <int DQK, int DV, bool NA, int KT>
DI void attn_phase(PRM p, const u16* Qf, const u16* Kf, const u16* VT, u16* O, int H, int KVH, float scale, const float* rpb,
                   bool do_lat, bool do_ctx, char* smem) {
  constexpr int KST = DQK + 8, VST = KT + 4, NKC = KT * DQK / 2048, NVC = DV * KT / 2048, KCH = DQK / 8, VCH = KT / 8, NKB = KT / 32, KR = KCH / 8, NDVB = DV / 32;
  const int tid = get_tid(), lane = tid & 63, wave = tid >> 6, hh = lane >> 5, ql = lane & 31;
  u16* sK = (u16*)smem; u16* sV = sK + KT * KST; float* sB = (float*)(sV + DV * VST);
  const int G = H / KVH;
  const int t_lo = do_lat ? 0 : 128 * H, t_hi = do_ctx ? 132 * H : 128 * H;
  const float sl2 = scale * LOG2E;
  const int kgo = (tid >> 3) * DQK + (tid & 7) * 8, kso = (tid >> 3) * KST + (tid & 7) * 8;
  const int vgo = (tid / VCH) * TEXT + (tid % VCH) * 8, vso = (tid / VCH) * VST + (tid % VCH) * 8;
  for (int tile = t_lo + get_bid(); tile < t_hi; tile += gridDim.x) {
    const int h = tile % H, mt = tile / H;
    const bool isctx = mt >= 128;
    const int m0 = isctx ? ML + (mt - 128) * 128 : mt * 128;
    const int b = isctx ? (mt - 128) >> 1 : mt >> 6;
    const int kvh = h / G;
    const u16* Kg = Kf + (size_t)(b * KVH + kvh) * TEXT * DQK;
    const u16* Vg = VT + (size_t)(b * KVH + kvh) * DV * TEXT;
    const int qrow = m0 + wave * 32 + ql;
    bf16x8 qf[DQK / 16];
#pragma unroll
    for (int kk = 0; kk < DQK / 16; ++kk) qf[kk] = *(const bf16x8*)(Qf + (size_t)qrow * (H * DQK) + h * DQK + kk * 16 + hh * 8);
    int nkt = isctx ? 256 / KT : TEXT / KT, rbase = 0, qr = 0, r0q = 0;
    if (NA) {
      int s0 = m0 & 8191, r1 = s0 >> 6;
      rbase = clampi(r1 - 4, 0, 120);
      nkt = 4 + (clampi(r1 + 1 - 4, 0, 120) + 8 - rbase);
      qr = (s0 + wave * 32) >> 6; r0q = clampi(qr - 4, 0, 120);
    }
    __syncthreads();
    if (NA) { for (int i = tid; i < 465; i += 256) sB[i] = rpb[h * 465 + i] * LOG2E; }
    f32x16 o[NDVB];
#pragma unroll
    for (int i = 0; i < NDVB; ++i)
#pragma unroll
      for (int j = 0; j < 16; ++j) o[i][j] = 0.f;
    float mrun = -1e30f, lrun = 0.f;
    u32x4 kr[NKC], vr[NVC];
    {
      const int t0 = 0;
#pragma unroll
      for (int i = 0; i < NKC; ++i) kr[i] = *(const u32x4*)(Kg + (unsigned)(t0 * DQK + kgo + 32 * (i / KR) * DQK + 64 * (i % KR)));
#pragma unroll
      for (int i = 0; i < NVC; ++i) vr[i] = *(const u32x4*)(Vg + (unsigned)(t0 + vgo + i * (256 / VCH) * TEXT));
    }
    for (int it = 0; it < nkt; ++it) {
      __syncthreads();
#pragma unroll
      for (int i = 0; i < NKC; ++i) *(u32x4*)(sK + kso + 32 * (i / KR) * KST + 64 * (i % KR)) = kr[i];
#pragma unroll
      for (int i = 0; i < NVC; ++i) {
        *(u32x2*)(sV + vso + i * (256 / VCH) * VST) = (u32x2){vr[i][0], vr[i][1]};
        *(u32x2*)(sV + vso + i * (256 / VCH) * VST + 4) = (u32x2){vr[i][2], vr[i][3]};
      }
      __syncthreads();
      if (it + 1 < nkt) {
        const int itn = it + 1;
        const int t0 = (NA && itn >= 4) ? 256 + (rbase + itn - 4) * 64 : itn * KT;
#pragma unroll
        for (int i = 0; i < NKC; ++i) kr[i] = *(const u32x4*)(Kg + (unsigned)(t0 * DQK + kgo + 32 * (i / KR) * DQK + 64 * (i % KR)));
#pragma unroll
        for (int i = 0; i < NVC; ++i) vr[i] = *(const u32x4*)(Vg + (unsigned)(t0 + vgo + i * (256 / VCH) * TEXT));
      }
      const int krow = rbase + it - 4;
      const bool local = NA && it >= 4;
      if (local && !(krow >= r0q && krow < r0q + 8)) continue;
      f32x16 s[NKB];
#pragma unroll
      for (int kb = 0; kb < NKB; ++kb)
#pragma unroll
        for (int j = 0; j < 16; ++j) s[kb][j] = 0.f;
      {
        constexpr int NKK = DQK / 16, NQK = NKB * NKK, RD = (DQK > 128 && KT == 64) ? 2 : 4;
        bf16x8 kf[NQK];
#define LDK(i) (*(const bf16x8*)(sK + (((i) / NKK) * 32 + ql) * KST + ((i) % NKK) * 16 + hh * 8))
#pragma unroll
        for (int i = 0; i < RD; ++i) kf[i] = LDK(i);
        __builtin_amdgcn_sched_barrier(0);
#pragma unroll
        for (int i = 0; i < NQK; ++i) {
          if (i + RD < NQK) kf[i + RD] = LDK(i + RD);
          s[i / NKK] = MFMA32(kf[i], qf[i % NKK], s[i / NKK]);
          __builtin_amdgcn_sched_barrier(0);
        }
#undef LDK
      }
      float mloc = -1e30f;
      if (local) {
        const int qc = (wave & 1) * 32 + ql, csq = clampi(qc - 8, 0, 48);
        const int bro = (krow - qr + 7) * 31 - qc + 15;
#pragma unroll
        for (int kb = 0; kb < NKB; ++kb)
#pragma unroll
          for (int i = 0; i < 16; ++i) {
            int kc = kb * 32 + (i & 3) + 8 * (i >> 2) + 4 * hh;
            bool ok = kc >= csq && kc < csq + 16;
            float x = ok ? s[kb][i] * sl2 + sB[bro + kc] : -1e30f;
            s[kb][i] = x; mloc = fmaxf(mloc, x);
          }
      } else {
#pragma unroll
        for (int kb = 0; kb < NKB; ++kb)
#pragma unroll
          for (int i = 0; i < 16; ++i) mloc = fmaxf(mloc, s[kb][i]);
        mloc *= sl2;
      }
      mloc = fmaxf(mloc, __shfl_xor(mloc, 32));
      const float mnew = fmaxf(mrun, mloc);
      if (__any(mnew > mrun)) {
        const float alpha = ex2(mrun - mnew);
        mrun = mnew;
        lrun *= alpha;
#pragma unroll
        for (int i = 0; i < NDVB; ++i)
#pragma unroll
          for (int j = 0; j < 16; ++j) o[i][j] *= alpha;
      }
      float ls = 0.f;
      if (local) {
#pragma unroll
        for (int kb = 0; kb < NKB; ++kb)
#pragma unroll
          for (int i = 0; i < 16; ++i) { float e = ex2(s[kb][i] - mrun); s[kb][i] = e; ls += e; }
      } else {
        const float nm = -mrun;
#pragma unroll
        for (int kb = 0; kb < NKB; ++kb)
#pragma unroll
          for (int i = 0; i < 16; ++i) { float e = ex2(fmaf(s[kb][i], sl2, nm)); s[kb][i] = e; ls += e; }
      }
      lrun += ls;
      {
        constexpr int NPV = NKB * 2 * NDVB, RD = (DQK > 128 && KT == 64) ? 2 : 4;
        bf16x8 pf[NKB * 2], vf[NPV];
#pragma unroll
        for (int c = 0; c < NKB * 2; ++c) {
          const int kb = c >> 1, st = c & 1;
          u32x4 pw = {pack2(s[kb][8 * st], s[kb][8 * st + 1]), pack2(s[kb][8 * st + 2], s[kb][8 * st + 3]),
                      pack2(s[kb][8 * st + 4], s[kb][8 * st + 5]), pack2(s[kb][8 * st + 6], s[kb][8 * st + 7])};
          pf[c] = __builtin_bit_cast(bf16x8, pw);
        }
#define LDV(j) ({ const u16* vp_ = sV + (((j) % NDVB) * 32 + ql) * VST + ((j) / NDVB) * 16 + hh * 4; \
                  bf16x4 lo_ = *(const bf16x4*)vp_, hi_ = *(const bf16x4*)(vp_ + 8); __builtin_shufflevector(lo_, hi_, 0, 1, 2, 3, 4, 5, 6, 7); })
#pragma unroll
        for (int j = 0; j < RD; ++j) vf[j] = LDV(j);
        __builtin_amdgcn_sched_barrier(0);
#pragma unroll
        for (int j = 0; j < NPV; ++j) {
          if (j + RD < NPV) vf[j + RD] = LDV(j + RD);
          o[j % NDVB] = MFMA32(vf[j], pf[j / NDVB], o[j % NDVB]);
          __builtin_amdgcn_sched_barrier(0);
        }
#undef LDV
      }
    }
    lrun += __shfl_xor(lrun, 32);
    const float inv = 1.f / lrun;
#pragma unroll
    for (int dvb = 0; dvb < NDVB; ++dvb)
#pragma unroll
      for (int g = 0; g < 4; ++g) {
        int dv = dvb * 32 + 8 * g + 4 * hh;
        *(uint2*)(O + (size_t)qrow * (H * DV) + h * DV + dv) =
            make_uint2(pack2(o[dvb][4 * g] * inv, o[dvb][4 * g + 1] * inv), pack2(o[dvb][4 * g + 2] * inv, o[dvb][4 * g + 3] * inv));
      }
  }
}

DI void phase_ret_scan(PRM p, char* smem) {
  const int tid = get_tid(), lane = tid & 63, wave = tid >> 6, fr = lane & 15, fq = lane >> 4;
  u16* sST = (u16*)smem;
  float* sKD = (float*)(smem + 16896);
  const unsigned vlo = fr * TEXT + fq * 8;
  const unsigned klo = (wave * 64 + fr) * TEXT + fq * 8;
  const unsigned plo = (wave * 32 + fr) * 128 + fq * 8;
  const unsigned qlo = (wave * 32 + fr) * 1024 + fq * 8;
  const unsigned ylo = (wave * 32 + fr) * 2048 + fq * 4;
  for (int item = get_bid(); item < 256; item += gridDim.x) {
    const int bh = item & 7, slice = item >> 3, b = bh >> 2, h = bh & 3, v0 = slice * 16;
    const float ld2[2] = {p.in[28][h] * LOG2E, p.in[29][h] * LOG2E};
    const u16* VTb = (const u16*)(p.arena + A3_VT) + (size_t)(bh * 512 + v0) * TEXT;
    const u16* KTb = (const u16*)(p.arena + A3_KT) + (size_t)(bh * 256) * TEXT;
    f32x4 S[2][4];
#pragma unroll
    for (int d = 0; d < 2; ++d)
#pragma unroll
      for (int r = 0; r < 4; ++r) S[d][r] = (f32x4){0.f, 0.f, 0.f, 0.f};
    __syncthreads();
    sKD[tid] = tid < 128 ? ex2((float)(127 - tid) * ld2[0]) : ex2((float)(tid - 128) * ld2[1]);
    __syncthreads();
    for (int st = 0; st < 66; ++st) {
#pragma unroll
      for (int d = 0; d < 2; ++d) {
        float l2 = ld2[d];
        asm volatile("" : "+v"(l2));
        int text0, n = 0;
        if (st < 2) text0 = (d == 0 ? st : 1 - st) * 128;
        else { n = d == 0 ? st - 2 : 63 - (st - 2); text0 = 256 + n * 128; }
        bf16x8 vfr[4], kfr[4][4];
#pragma unroll
        for (int ks = 0; ks < 4; ++ks) vfr[ks] = *(const bf16x8*)(VTb + (vlo + text0 + ks * 32));
        if (st >= 2) {
          const int mrow = b * 8192 + n * 128;
          const bool first = (st - 2) < 32;
          const u16* Pb = (const u16*)(p.arena + A3_P) + (size_t)d * 512 * 128 * 128 + (size_t)(bh * 64 + n) * 16384;
          const u16* Qb = p.xn + (size_t)mrow * 1024 + h * 256;
          u16* Yb = (u16*)(p.arena + A3_Y) + (size_t)mrow * 2048 + h * 512 + v0;
#pragma unroll 1
          for (int ot = 0; ot < 2; ++ot) {
            f32x4 ain = (f32x4){0.f, 0.f, 0.f, 0.f}, acr = (f32x4){0.f, 0.f, 0.f, 0.f};
            bf16x8 pa[4], qa[8];
#pragma unroll
            for (int ks = 0; ks < 4; ++ks) pa[ks] = *(const bf16x8*)(Pb + (plo + ot * 16 * 128 + ks * 32));
#pragma unroll
            for (int ks = 0; ks < 8; ++ks) qa[ks] = *(const bf16x8*)(Qb + (qlo + ot * 16 * 1024 + ks * 32));
            u32x2 yw = *(const u32x2*)(Yb + (ylo + ot * 16 * 2048));
            if (first) yw = (u32x2){0u, 0u};
            f32x4 yold;
            yold[0] = __uint_as_float(yw[0] << 16); yold[1] = __uint_as_float(yw[0] & 0xffff0000u);
            yold[2] = __uint_as_float(yw[1] << 16); yold[3] = __uint_as_float(yw[1] & 0xffff0000u);
#pragma unroll
            for (int ks = 0; ks < 4; ++ks) ain = MFMA16(vfr[ks], pa[ks], ain);
            f32x4 acr2 = (f32x4){0.f, 0.f, 0.f, 0.f};
#pragma unroll
            for (int ks = 0; ks < 8; ks += 2) {
              bf16x8 bb0 = *(const bf16x8*)(sST + (d * 16 + fr) * 264 + ks * 32 + fq * 8);
              bf16x8 bb1 = *(const bf16x8*)(sST + (d * 16 + fr) * 264 + (ks + 1) * 32 + fq * 8);
              acr = MFMA16(bb0, qa[ks], acr);
              acr2 = MFMA16(bb1, qa[ks + 1], acr2);
            }
            acr += acr2;
            {
              const int q = wave * 32 + ot * 16 + fr;
              const float qd = d == 0 ? ex2((float)(q + 1) * l2) : ex2((float)(128 - q) * l2);
              *(u32x2*)(Yb + (ylo + ot * 16 * 2048)) = (u32x2){pack2(ain[0] + acr[0] * qd + yold[0], ain[1] + acr[1] * qd + yold[1]),
                                                              pack2(ain[2] + acr[2] * qd + yold[2], ain[3] + acr[3] * qd + yold[3])};
            }
          }
        }
#pragma unroll
        for (int rt = 0; rt < 4; ++rt)
#pragma unroll
          for (int ks = 0; ks < 4; ++ks) kfr[rt][ks] = *(const bf16x8*)(KTb + (klo + rt * 16 * TEXT + text0 + ks * 32));
        const float cd = ex2(128.f * l2);
#pragma unroll
        for (int ks = 0; ks < 4; ++ks) {
          unsigned w[4];
          const f32x4 k0 = *(const f32x4*)(sKD + d * 128 + ks * 32 + fq * 8), k1 = *(const f32x4*)(sKD + d * 128 + ks * 32 + fq * 8 + 4);
          w[0] = pack2(bf2f((u16)vfr[ks][0]) * k0[0], bf2f((u16)vfr[ks][1]) * k0[1]);
          w[1] = pack2(bf2f((u16)vfr[ks][2]) * k0[2], bf2f((u16)vfr[ks][3]) * k0[3]);
          w[2] = pack2(bf2f((u16)vfr[ks][4]) * k1[0], bf2f((u16)vfr[ks][5]) * k1[1]);
          w[3] = pack2(bf2f((u16)vfr[ks][6]) * k1[2], bf2f((u16)vfr[ks][7]) * k1[3]);
          vfr[ks] = __builtin_bit_cast(bf16x8, (u32x4){w[0], w[1], w[2], w[3]});
        }
#pragma unroll
        for (int rt = 0; rt < 4; ++rt) {
          S[d][rt] *= cd;
#pragma unroll
          for (int ks = 0; ks < 4; ++ks) S[d][rt] = MFMA16(kfr[rt][ks], vfr[ks], S[d][rt]);
        }
        __builtin_amdgcn_sched_barrier(0);
      }
      __syncthreads();
#pragma unroll
      for (int d = 0; d < 2; ++d)
#pragma unroll
        for (int rt = 0; rt < 4; ++rt)
          *(uint2*)(sST + (d * 16 + fr) * 264 + wave * 64 + rt * 16 + fq * 4) = make_uint2(pack2(S[d][rt][0], S[d][rt][1]), pack2(S[d][rt][2], S[d][rt][3]));
      __syncthreads();
    }
  }
}

#define XB_TMO      128
#define XB_XCNT(j)  (256  + 64 * (j))
#define XB_XSUB(j)  (1280 + 64 * (j))
#define XB_XGEN(j)  (2304 + 64 * (j))
#define XB_TOP      3328
#define XB_TOPGEN   3392
#define XCD_BAR_WORDS 3456
#define XB_SPIN_CAP (1u << 18)
#define LAS __attribute__((address_space(3)))

__device__ __forceinline__ unsigned xb_ld(unsigned* p)              { return __hip_atomic_load(p, __ATOMIC_RELAXED, __HIP_MEMORY_SCOPE_AGENT); }
__device__ __forceinline__ unsigned xb_add(unsigned* p, unsigned v) { return __hip_atomic_fetch_add(p, v, __ATOMIC_RELAXED, __HIP_MEMORY_SCOPE_AGENT); }
__device__ __forceinline__ unsigned xb_xcc_id() { return (unsigned)__builtin_amdgcn_s_getreg((3 << 11) | 20) & 0xFu; }
#define XB_SPIN(cond, bar) do { unsigned _sp = 0; while (cond) { __builtin_amdgcn_s_sleep(1); \
    if ((++_sp & 255u) == 0u) { if (xb_ld(&(bar)[XB_TMO])) break; if (_sp > XB_SPIN_CAP) { atomicAdd(&(bar)[XB_TMO], 1u); break; } } } } while (0)

struct XcdBarrier {
    unsigned* bar; unsigned x;
    volatile LAS unsigned* st;
};

__device__ __forceinline__ XcdBarrier xcd_barrier_post(unsigned* bar, volatile LAS unsigned* st) {
    XcdBarrier b; b.bar = bar; b.x = xb_xcc_id(); b.st = st;
    if (threadIdx.x == 0) (void)xb_add(&bar[XB_XCNT(b.x)], 1u);
    return b;
}
__device__ __forceinline__ void xcd_barrier_complete(unsigned* bar, unsigned x, unsigned& nloc, unsigned& nx) {
    const unsigned G = gridDim.x * gridDim.y * gridDim.z;
    unsigned sum, cnt, mine, sp = 0u;
    for (;;) {
        sum = 0u; cnt = 0u; mine = 0u;
#pragma unroll
        for (unsigned j = 0; j < 16; ++j) { const unsigned c = xb_ld(&bar[XB_XCNT(j)]); sum += c; cnt += (c > 0u) ? 1u : 0u; mine = (j == x) ? c : mine; }
        if (sum == G) break;
        __builtin_amdgcn_s_sleep(1);
        if ((++sp & 255u) == 0u) { if (xb_ld(&bar[XB_TMO])) break; if (sp > XB_SPIN_CAP) { atomicAdd(&bar[XB_TMO], 1u); break; } }
    }
    nloc = mine > 0u ? mine : 1u; nx = cnt > 0u ? cnt : 1u;
}

__device__ __forceinline__ void xcd_barrier(const XcdBarrier& b) {
    asm volatile("s_waitcnt vmcnt(0)" ::: "memory");
    __syncthreads();
    if (threadIdx.x == 0) {
        unsigned* bar = b.bar;
        __builtin_amdgcn_s_waitcnt(0);
        unsigned nloc = b.st[0], nx = b.st[1];
        if (nloc == 0u) { xcd_barrier_complete(bar, b.x, nloc, nx); b.st[0] = nloc; b.st[1] = nx; }
        const unsigned old = xb_add(&bar[XB_XSUB(b.x)], 1u);
        const unsigned gen = old / nloc;
        if (old + 1u == (gen + 1u) * nloc) {
            __builtin_amdgcn_fence(__ATOMIC_RELEASE, "agent");
            asm volatile("s_waitcnt vmcnt(0)" ::: "memory");
            const unsigned og = xb_add(&bar[XB_TOP], 1u);
            const unsigned tg = og / nx;
            if (og + 1u == (tg + 1u) * nx) xb_add(&bar[XB_TOPGEN], 1u);
            else XB_SPIN(xb_ld(&bar[XB_TOPGEN]) == tg, bar);
            __builtin_amdgcn_fence(__ATOMIC_ACQUIRE, "agent");
            xb_add(&bar[XB_XGEN(b.x)], 1u);
            asm volatile("s_waitcnt vmcnt(0)" ::: "memory");
        } else {
            XB_SPIN(xb_ld(&bar[XB_XGEN(b.x)]) == gen, bar);
            __builtin_amdgcn_fence(__ATOMIC_ACQUIRE, "agent");
            asm volatile("s_waitcnt vmcnt(0)" ::: "memory");
        }
    }
    __syncthreads();
}


__global__ void __launch_bounds__(256, 2) fwd_megakernel(Params p_unused) {
  typedef const __attribute__((address_space(4))) Params CParams;
  __shared__ __attribute__((aligned(16))) char smem[61440];
  cg::grid_group grid = cg::this_grid();
  int rep = 0;
  CParams* pp0 = (CParams*)__builtin_amdgcn_kernarg_segment_ptr();
  __shared__ uint4 xb_words;
  if (threadIdx.x == 0) xb_words = make_uint4(0u, 0u, 0u, 0u);
  __syncthreads();
  XcdBarrier xb = xcd_barrier_post(pp0->bar, (volatile LAS unsigned*)&xb_words);
  const int ph_lo = pp0->phase_lo, ph_hi = pp0->phase_hi;
  for (int ph = ph_lo; ph < ph_hi; ++ph) {
    CParams* pp = pp0;
    asm volatile("" : "+s"(pp));
    PRM p = *pp;
    switch (ph) {
      case 0: phase_init(p, smem); break;
      case 1: phase_norm(p, 0, 0, MALL); break;
      case 11: convert_layer(p, 1, smem); phase_norm(p, 1, 0, MALL); break;
      case 19: convert_layer(p, 2, smem); phase_norm(p, 2, 0, MALL); break;
      case 27: convert_layer(p, 3, smem); phase_norm(p, 3, 0, MALL); break;
      case 8: phase_norm(p, 0, 1, MALL); break;
      case 16: phase_norm(p, 1, 1, MALL); break;
      case 24: phase_norm(p, 2, 1, MALL); break;
      case 34: phase_norm(p, 3, 1, MALL); break;
      case 3: phase_mla_post1(p); break;
      case 5: phase_mla_post2(p); break;
      case 13: phase_gqa_post(p); break;
      case 21: phase_na_post(p); break;
      case 29: phase_ret_post(p, smem); break;
      case 6:
        attn_phase<192, 128, false, 64>(p, (const u16*)(p.arena + A0_Q), (const u16*)(p.arena + A0_K), (const u16*)(p.arena + A0_VT), (u16*)(p.arena + A0_O), 8, 8,
                                    0.07216878364870322f, nullptr, true, true, smem);
        break;
      case 14:
        attn_phase<128, 128, false, 64>(p, (const u16*)(p.arena + A1_Q), (const u16*)(p.arena + A1_K), (const u16*)(p.arena + A1_VT), (u16*)(p.arena + A1_O), 8, 2,
                                    0.08838834764831845f, nullptr, true, true, smem);
        break;
      case 22:
        attn_phase<64, 64, true, 64>(p, (const u16*)(p.arena + A2_Q), (const u16*)(p.arena + A2_K), (const u16*)(p.arena + A2_VT), (u16*)(p.arena + A2_O), 16, 16,
                                 0.125f, p.in[25], true, false, smem);
        attn_phase<64, 64, false, 64>(p, (const u16*)(p.arena + A2_Q), (const u16*)(p.arena + A2_K), (const u16*)(p.arena + A2_VT), (u16*)(p.arena + A2_O), 16, 16,
                                  0.125f, nullptr, false, true, smem);
        break;
      case 31: phase_ret_scan(p, smem); break;
      case 32: phase_ret_gate(p); break;
      default:
#ifdef DBG_SKIP
        if (ph == DBG_SKIP) break;
#endif
        gemm_phase(p, ph, smem); break;
    }
#ifdef REPEAT_PH
    if (ph == REPEAT_PH && !rep) { rep = 1; xcd_barrier(xb); --ph; continue; }
    rep = 0;
#endif
    if (ph + 1 < ph_hi) { if (ph_lo < 0) grid.sync(); else xcd_barrier(xb); }
  }
}

extern "C" void kernel_launch(void* const* d_in, const int* in_sizes, int n_in, void* d_out, int out_size, void* d_ws, size_t ws_size,
                              hipStream_t stream) {
  static int grid_blocks = 0;
  if (!grid_blocks) {
    int dev = 0, cus = 0, per_cu = 0;
    hipGetDevice(&dev);
    hipDeviceGetAttribute(&cus, hipDeviceAttributeMultiprocessorCount, dev);
    hipOccupancyMaxActiveBlocksPerMultiprocessor(&per_cu, fwd_megakernel, 256, 0);
    if (per_cu > 2) per_cu = 2;
    grid_blocks = cus * per_cu;
  }
  Params p{};
  for (int i = 0; i < 32; ++i) p.in[i] = (const float*)d_in[i];
  p.out = (float*)d_out;
  char* ws = (char*)d_ws;
  size_t off = 0;
  p.modv = (float*)(ws + off); off += 4 * 3 * 6144 * 4;
  p.tab = (float2*)(ws + off); off += 128 * 112 * 8;
  p.hctx = (float*)(ws + off); off += (size_t)512 * 1024 * 4;
  p.wt = (u16*)(ws + off); off += WT_ELEMS * 2;
  p.xn = (u16*)(ws + off); off += (size_t)MALL * 1024 * 2;
  p.arena = ws + off; off += ARENA_BYTES;
  p.bar = (unsigned*)(ws + off); off += XCD_BAR_WORDS * 4;
  if (off > ws_size) { fprintf(stderr, "workspace too small: need %zu have %zu\n", off, ws_size); return; }
  p.phase_lo = 0; p.phase_hi = NPHASE;
  (void)hipMemsetAsync(p.bar, 0, XCD_BAR_WORDS * 4, stream);
  void* args[] = {&p};
  hipError_t e = hipLaunchCooperativeKernel((void*)fwd_megakernel, dim3(grid_blocks), dim3(256), args, 0, stream);
  if (e != hipSuccess) fprintf(stderr, "cooperative launch failed: %s (grid %d)\n", hipGetErrorString(e), grid_blocks);
}
```
